# Optimizing an MI355X kernel written in HIP

```python
import math
import jax, jax.numpy as jnp
from jax import lax
import numpy as np


D_MODEL = 2048
BATCH = 4
SEQ = 4096
DEPTH = 4

GRID_W = 64
CTX_LEN = 256
N_MIXERS = 4
CTX_READERS = (0, 1, 2)
RMS_EPS = 1e-6
ROPE_THETA = 10000.0
D_FF = 4 * D_MODEL
N_MOD = 6

SWA_HEADS = 16
SWA_KV_HEADS = 4
SWA_GROUP = SWA_HEADS // SWA_KV_HEADS
SWA_HEAD_DIM = D_MODEL // SWA_HEADS
SWA_WINDOW = 128
SWA_BLOCK = 128

ML_HEADS = 8
ML_DV = D_MODEL // ML_HEADS
ML_DQK = ML_DV // 2
ML_CHUNK = 64
ML_F_BIAS_LO = 3.0
ML_F_BIAS_HI = 6.0

MLA_HEADS = 16
MLA_Q_RANK = 512
MLA_KV_RANK = 512
MLA_NOPE = 128
MLA_ROPE = 64
MLA_V = 128
MLA_BLOCK = 128

HY_ORDER = 2
HY_BANDS = 16
HY_EMB = 1 + 2 * HY_BANDS
HY_FILTER_W = 64
HY_SHORT = 3
HY_MIN_DECAY = -math.log(1e-2) / 1.5
HY_MAX_DECAY = -math.log(1e-2) / 0.3

kernel_name = 'hybrid_interleaved_dit_trunk'


def rmsnorm(x, g):
    xf = x.astype(jnp.float32)
    y = xf * lax.rsqrt(jnp.mean(xf * xf, axis=-1, keepdims=True) + RMS_EPS)
    return (y * g.astype(jnp.float32)).astype(x.dtype)


def modulate(x, shift, scale):
    return x * (1 + scale) + shift


def sqrelu_mlp(u, w1, w2):
    return jnp.square(jax.nn.relu(u @ w1)) @ w2


def axial_rope_tables(row, col, d_rot):
    n = d_rot // 4
    inv = ROPE_THETA ** (-jnp.arange(n, dtype=jnp.float32) / n)
    ang = jnp.concatenate([row.astype(jnp.float32)[:, None] * inv, col.astype(jnp.float32)[:, None] * inv], axis=-1)
    return jnp.cos(ang), jnp.sin(ang)


def apply_rope(x, cos, sin):
    half = x.shape[-1] // 2
    x1, x2 = x[..., :half], x[..., half:]
    c = cos[:, None, :].astype(x.dtype)
    s = sin[:, None, :].astype(x.dtype)
    return jnp.concatenate([x1 * c - x2 * s, x2 * c + x1 * s], axis=-1)


def dense_attention(q, k, v, scale):
    s = jnp.einsum('bqhd,bkhd->bhqk', q, k).astype(jnp.float32) * scale
    p = jax.nn.softmax(s, axis=-1).astype(v.dtype)
    return jnp.einsum('bhqk,bkhd->bqhd', p, v)


def window_gqa_mixer(u, uc, w_qkv, sink, w_o, rope_cs, need_ctx):
    B, S, _ = u.shape
    H, KV, G, HD, LB = SWA_HEADS, SWA_KV_HEADS, SWA_GROUP, SWA_HEAD_DIM, SWA_BLOCK
    scale = HD ** -0.5

    def project(a):
        T = a.shape[1]
        qkv = a @ w_qkv
        q = qkv[..., :H * HD].reshape(B, T, H, HD)
        k = qkv[..., H * HD:(H + KV) * HD].reshape(B, T, KV, HD)
        v = qkv[..., (H + KV) * HD:].reshape(B, T, KV, HD)
        return q, k, v

    q, k, v = project(u)
    q, k = apply_rope(q, *rope_cs), apply_rope(k, *rope_cs)
    qc, kc, vc = project(uc)
    t_ctx = uc.shape[1]
    sink_kg = sink.astype(jnp.float32).reshape(KV, G)

    nb = S // LB
    qb = q.reshape(B, nb, LB, KV, G, HD)

    def band(a):
        ab = jnp.pad(a.reshape(B, nb, LB, KV, HD), ((0, 0), (1, 1), (0, 0), (0, 0), (0, 0)))
        return jnp.concatenate([ab[:, :-2], ab[:, 1:-1], ab[:, 2:]], axis=2)

    kb, vb = band(k), band(v)
    s_loc = jnp.einsum('bnqkgd,bnjkd->bnkgqj', qb, kb).astype(jnp.float32) * scale
    blk = jnp.arange(nb)[:, None, None]
    qpos = blk * LB + jnp.arange(LB)[None, :, None]
    kpos = (blk - 1) * LB + jnp.arange(3 * LB)[None, None, :]
    valid = (jnp.abs(kpos - qpos) <= SWA_WINDOW) & (kpos >= 0) & (kpos < S)
    s_loc = jnp.where(valid[None, :, None, None], s_loc, -jnp.inf)
    s_ctx = jnp.einsum('bnqkgd,bjkd->bnkgqj', qb, kc).astype(jnp.float32) * scale
    s_snk = jnp.broadcast_to(sink_kg[None, None, :, :, None, None], s_loc.shape[:-1] + (1,))
    p = jax.nn.softmax(jnp.concatenate([s_loc, s_ctx, s_snk], axis=-1), axis=-1)
    p_loc = p[..., :3 * LB].astype(v.dtype)
    p_ctx = p[..., 3 * LB:3 * LB + t_ctx].astype(v.dtype)
    o = jnp.einsum('bnkgqj,bnjkd->bnqkgd', p_loc, vb) + jnp.einsum('bnkgqj,bjkd->bnqkgd', p_ctx, vc)
    y = o.reshape(B, S, H * HD) @ w_o
    yc = None
    if need_ctx:
        qcg = qc.reshape(B, t_ctx, KV, G, HD)
        sc = jnp.einsum('bqkgd,bjkd->bkgqj', qcg, kc).astype(jnp.float32) * scale
        sc_snk = jnp.broadcast_to(sink_kg[None, :, :, None, None], sc.shape[:-1] + (1,))
        pc = jax.nn.softmax(jnp.concatenate([sc, sc_snk], axis=-1), axis=-1)[..., :t_ctx]
        oc = jnp.einsum('bkgqj,bjkd->bqkgd', pc.astype(vc.dtype), vc)
        yc = oc.reshape(B, t_ctx, H * HD) @ w_o
    return y, yc


def mlstm_chunked(q, k, v, i_pre, log_f, state):
    B, H, T, _ = q.shape
    n_ch = T // ML_CHUNK
    tril = jnp.tril(jnp.ones((ML_CHUNK, ML_CHUNK), dtype=bool))

    def to_chunks(a):
        return jnp.moveaxis(a.reshape((B, H, n_ch, ML_CHUNK) + a.shape[3:]), 2, 0)

    def step(carry, chunk):
        C, n, m = carry
        qs, ks, vs, ic, fc = chunk
        b = jnp.cumsum(fc, axis=-1)
        dmat = jnp.where(tril, b[..., :, None] - b[..., None, :] + ic[..., None, :], -jnp.inf)
        inter = b + m[..., None]
        m_t = jnp.maximum(inter, jnp.max(dmat, axis=-1))
        w = jnp.exp(dmat - m_t[..., None])
        g = jnp.exp(inter - m_t)
        s = jnp.einsum('bhtd,bhsd->bhts', qs, ks) * w
        num = jnp.einsum('bhts,bhsv->bhtv', s, vs) + g[..., None] * jnp.einsum('bhvd,bhtd->bhtv', C, qs)
        den = jnp.sum(s, axis=-1) + g * jnp.einsum('bhd,bhtd->bht', n, qs)
        h = num / jnp.maximum(jnp.abs(den), jnp.exp(-m_t))[..., None]
        b_end = b[..., -1]
        dec = b_end[..., None] - b + ic
        m_new = jnp.maximum(b_end + m, jnp.max(dec, axis=-1))
        ws = jnp.exp(dec - m_new[..., None])
        gs = jnp.exp(b_end + m - m_new)
        C = gs[..., None, None] * C + jnp.einsum('bhs,bhsv,bhsd->bhvd', ws, vs, ks)
        n = gs[..., None] * n + jnp.einsum('bhs,bhsd->bhd', ws, ks)
        return (C, n, m_new), h

    state, h = lax.scan(step, state, tuple(to_chunks(a) for a in (q, k, v, i_pre, log_f)))
    h = jnp.moveaxis(h, 0, 2).reshape(B, H, T, v.shape[-1])
    return h, state


def mlstm_mixer(u, uc, w_in, gate_b, head_g, w_o, need_ctx):
    H, DQK, DV = ML_HEADS, ML_DQK, ML_DV
    f32 = jnp.float32
    o1, o2 = H * DQK, 2 * H * DQK
    o3, o4 = o2 + H * DV, o2 + 2 * H * DV

    def project(a):
        B, T, _ = a.shape
        z = a @ w_in
        heads = lambda t, d: jnp.moveaxis(t.reshape(B, T, H, d), 1, 2).astype(f32)
        q = heads(z[..., :o1], DQK) * DQK ** -0.5
        k = heads(z[..., o1:o2], DQK)
        v = heads(z[..., o2:o3], DV)
        og = jax.nn.sigmoid(z[..., o3:o4])
        g = z[..., o4:].astype(f32).reshape(B, T, 2, 2, H) + gate_b.astype(f32)
        i_pre = jnp.moveaxis(g[:, :, 0], 1, -1)
        log_f = jax.nn.log_sigmoid(jnp.moveaxis(g[:, :, 1], 1, -1))
        return (q, k, v, i_pre, log_f), og

    lat, og = project(u)
    ctx_seq, og_c = project(uc)
    B = u.shape[0]
    zero = (jnp.zeros((B, H, DV, DQK), f32), jnp.zeros((B, H, DQK), f32), jnp.zeros((B, H), f32))

    def run(seq, d, state, reverse):
        q, k, v, i_pre, log_f = seq
        parts = (q, k, v, i_pre[:, d], log_f[:, d])
        if reverse:
            parts = tuple(jnp.flip(a, axis=2) for a in parts)
        h, st = mlstm_chunked(*parts, state)
        return (jnp.flip(h, axis=2) if reverse else h), st

    hc_f, st_f = run(ctx_seq, 0, zero, False)
    hl_f, _ = run(lat, 0, st_f, False)
    hc_b, st_b = run(ctx_seq, 1, zero, True)
    hl_b, _ = run(lat, 1, st_b, True)

    def finish(hsum, gate):
        Bq, _, T, _ = hsum.shape
        hn = rmsnorm(jnp.moveaxis(hsum, 1, 2), head_g.reshape(H, DV))
        return (hn.reshape(Bq, T, H * DV).astype(gate.dtype) * gate) @ w_o

    y = finish(hl_f + hl_b, og)
    yc = finish(hc_f + hc_b, og_c) if need_ctx else None
    return y, yc


def mla_mixer(u, uc, w_in, q_g, kv_g, w_uq, w_ukv, w_o, rope_cs, need_ctx):
    H, NP, RP, VD = MLA_HEADS, MLA_NOPE, MLA_ROPE, MLA_V
    scale = (NP + RP) ** -0.5
    r1, r2 = MLA_Q_RANK, MLA_Q_RANK + MLA_KV_RANK

    def queries(z, cs):
        B, T, _ = z.shape
        q = (rmsnorm(z[..., :r1], q_g) @ w_uq).reshape(B, T, H, NP + RP)
        if cs is None:
            return q
        return jnp.concatenate([q[..., :NP], apply_rope(q[..., NP:], *cs)], axis=-1)

    def keys_values(z, cs):
        B, T, _ = z.shape
        kv = (rmsnorm(z[..., r1:r2], kv_g) @ w_ukv).reshape(B, T, H, NP + VD)
        k_rope = z[..., r2:][:, :, None, :]
        if cs is not None:
            k_rope = apply_rope(k_rope, *cs)
        k = jnp.concatenate([kv[..., :NP], jnp.broadcast_to(k_rope, (B, T, H, RP))], axis=-1)
        return k, kv[..., NP:]

    z, zc = u @ w_in, uc @ w_in
    q = queries(z, rope_cs)
    k, v = keys_values(z, rope_cs)
    kc, vc = keys_values(zc, None)
    k_all = jnp.concatenate([k, kc], axis=1)
    v_all = jnp.concatenate([v, vc], axis=1)
    B, S, _ = u.shape
    nb = S // MLA_BLOCK
    qb = jnp.moveaxis(q.reshape(B, nb, MLA_BLOCK, H, NP + RP), 1, 0)
    o = lax.map(lambda qblk: dense_attention(qblk, k_all, v_all, scale), qb)
    y = jnp.moveaxis(o, 0, 1).reshape(B, S, H * VD) @ w_o
    yc = None
    if need_ctx:
        oc = dense_attention(queries(zc, None), kc, vc, scale)
        yc = oc.reshape(B, uc.shape[1], H * VD) @ w_o
    return y, yc


def short_conv(a, w, b):
    T = a.shape[1]
    pad = HY_SHORT // 2
    ap = jnp.pad(a, ((0, 0), (pad, pad), (0, 0)))
    return sum(ap[:, tap:tap + T] * w[tap] for tap in range(HY_SHORT)) + b


def hyena_filter_spectra(L, w1, b1, w2, b2, w3, b3, w4, b4, freq, decay):
    f32 = jnp.float32
    D = w4.shape[-1] // (2 * HY_ORDER)
    t = jnp.linspace(0.0, 1.0, L, dtype=f32)[:, None]
    w = (2.0 * math.pi / L) * jnp.arange(L, dtype=f32)[:, None]
    bands = jnp.linspace(1e-4, HY_BANDS - 1, HY_BANDS, dtype=f32)[None, :]
    feats = jnp.concatenate([t, jnp.cos(bands * w), -jnp.sin(bands * w)], axis=-1)
    fr = freq.astype(f32)
    a = jnp.sin(fr * (feats @ w1.astype(f32) + b1.astype(f32)))
    a = jnp.sin(fr * (a @ w2.astype(f32) + b2.astype(f32)))
    a = jnp.sin(fr * (a @ w3.astype(f32) + b3.astype(f32)))
    filt = (a @ w4.astype(f32) + b4.astype(f32)) * jnp.exp(-t * jnp.abs(decay.astype(f32)))
    filt = filt.reshape(L, 2, HY_ORDER, D)
    circ = jnp.concatenate([filt[:, 0], jnp.zeros((1, HY_ORDER, D), f32), filt[:0:-1, 1]], axis=0)
    return jnp.fft.rfft(circ, axis=0)


def fft_long_conv(z, spec, skip):
    L = z.shape[1]
    zf32 = z.astype(jnp.float32)
    zf = jnp.fft.rfft(zf32, n=2 * L, axis=1)
    y = jnp.fft.irfft(zf * spec, n=2 * L, axis=1)[:, :L]
    return (y + zf32 * skip.astype(jnp.float32)).astype(z.dtype)


def hyena_mixer(u, uc, w_in, conv_w, conv_b, f_w1, f_b1, f_w2, f_b2, f_w3, f_b3, f_w4, f_b4, f_freq, decay, skip, w_o, need_ctx):
    def run(a):
        L = a.shape[1]
        spec = hyena_filter_spectra(L, f_w1, f_b1, f_w2, f_b2, f_w3, f_b3, f_w4, f_b4, f_freq, decay)
        x1, x2, v = jnp.split(short_conv(a @ w_in, conv_w, conv_b), 3, axis=-1)
        y = x1 * fft_long_conv(v, spec[:, 0], skip[0])
        y = x2 * fft_long_conv(y, spec[:, 1], skip[1])
        return y @ w_o
    return run(u), (run(uc) if need_ctx else None)


def setup_inputs(seed: int = 0) -> dict:
    key = jax.random.key(seed)
    keys = iter(jax.random.split(key, 48))
    f32 = jnp.float32
    D = D_MODEL

    def normal(shape, s=1.0):
        return s * jax.random.normal(next(keys), shape, f32)

    def dense(shape, gain=1.0):
        return normal(shape, gain * shape[-2] ** -0.5)

    nA, nB, nC, nD = (len(range(kind, DEPTH, N_MIXERS)) for kind in range(N_MIXERS))
    ml_i_b = normal((nB, 1, 2, ML_HEADS), 0.1)
    ml_f_b = jnp.linspace(ML_F_BIAS_LO, ML_F_BIAS_HI, ML_HEADS, dtype=f32) + normal((nB, 1, 2, ML_HEADS), 0.1)
    hy_decay = jnp.linspace(HY_MIN_DECAY, HY_MAX_DECAY, 2 * HY_ORDER * D, dtype=f32) + normal((nD, 2 * HY_ORDER * D), 0.1)
    return {
        'x': normal((BATCH, SEQ, D)),
        'c': normal((BATCH, D)),
        'ctx': normal((BATCH, CTX_LEN, D)),
        'c_ctx': normal((D,)),
        'ada_w': dense((DEPTH, D, N_MOD * D), 0.5),
        'ada_b': normal((DEPTH, N_MOD * D), 0.02),
        'norm_g': 1.0 + normal((DEPTH, 4, D), 0.05),
        'mlp_w1': dense((DEPTH, D, D_FF)),
        'mlp_w2': dense((DEPTH, D_FF, D)),
        'swa_w_qkv': dense((nA, D, (SWA_HEADS + 2 * SWA_KV_HEADS) * SWA_HEAD_DIM)),
        'swa_sink': normal((nA, SWA_HEADS), 0.5),
        'swa_w_o': dense((nA, SWA_HEADS * SWA_HEAD_DIM, D)),
        'ml_w_in': dense((nB, D, 2 * ML_HEADS * ML_DQK + 2 * ML_HEADS * ML_DV + 4 * ML_HEADS)),
        'ml_gate_b': jnp.concatenate([ml_i_b, ml_f_b], axis=1),
        'ml_head_g': 1.0 + normal((nB, ML_HEADS * ML_DV), 0.05),
        'ml_w_o': dense((nB, ML_HEADS * ML_DV, D)),
        'mla_w_in': dense((nC, D, MLA_Q_RANK + MLA_KV_RANK + MLA_ROPE)),
        'mla_q_g': 1.0 + normal((nC, MLA_Q_RANK), 0.05),
        'mla_kv_g': 1.0 + normal((nC, MLA_KV_RANK), 0.05),
        'mla_w_uq': dense((nC, MLA_Q_RANK, MLA_HEADS * (MLA_NOPE + MLA_ROPE))),
        'mla_w_ukv': dense((nC, MLA_KV_RANK, MLA_HEADS * (MLA_NOPE + MLA_V))),
        'mla_w_o': dense((nC, MLA_HEADS * MLA_V, D)),
        'hy_w_in': dense((nD, D, 3 * D)),
        'hy_conv_w': normal((nD, HY_SHORT, 3 * D), HY_SHORT ** -0.5),
        'hy_conv_b': normal((nD, 3 * D), 0.02),
        'hy_f_w1': dense((nD, HY_EMB, HY_FILTER_W)),
        'hy_f_b1': normal((nD, HY_FILTER_W), 0.1),
        'hy_f_w2': dense((nD, HY_FILTER_W, HY_FILTER_W)),
        'hy_f_b2': normal((nD, HY_FILTER_W), 0.1),
        'hy_f_w3': dense((nD, HY_FILTER_W, HY_FILTER_W)),
        'hy_f_b3': normal((nD, HY_FILTER_W), 0.1),
        'hy_f_w4': dense((nD, HY_FILTER_W, 2 * HY_ORDER * D), 0.1),
        'hy_f_b4': normal((nD, 2 * HY_ORDER * D), 0.02),
        'hy_f_freq': 1.0 + normal((nD, HY_FILTER_W), 0.05),
        'hy_decay': hy_decay,
        'hy_skip': normal((nD, HY_ORDER, D), 0.5),
        'hy_w_o': dense((nD, D, D)),
    }


def reference(x, c, ctx, c_ctx, ada_w, ada_b, norm_g, mlp_w1, mlp_w2,
              swa_w_qkv, swa_sink, swa_w_o,
              ml_w_in, ml_gate_b, ml_head_g, ml_w_o,
              mla_w_in, mla_q_g, mla_kv_g, mla_w_uq, mla_w_ukv, mla_w_o,
              hy_w_in, hy_conv_w, hy_conv_b, hy_f_w1, hy_f_b1, hy_f_w2, hy_f_b2,
              hy_f_w3, hy_f_b3, hy_f_w4, hy_f_b4, hy_f_freq, hy_decay, hy_skip, hy_w_o):
    S = x.shape[1]
    rows = S // GRID_W
    row = jnp.repeat(jnp.arange(rows, dtype=jnp.int32), GRID_W)
    col = jnp.broadcast_to(jnp.arange(GRID_W, dtype=jnp.int32)[None, :], (rows, GRID_W)).reshape(-1)
    rope_swa = axial_rope_tables(row, col, SWA_HEAD_DIM)
    rope_mla = axial_rope_tables(row, col, MLA_ROPE)
    s_lat = jax.nn.silu(c)
    s_ctx = jax.nn.silu(c_ctx)
    h, hc = x, ctx
    for i in range(DEPTH):
        kind, j = i % N_MIXERS, i // N_MIXERS
        ctx_after = any(l % N_MIXERS in CTX_READERS for l in range(i + 1, DEPTH))
        ctx_in = ctx_after or (kind in CTX_READERS)
        m_lat = [m[:, None, :] for m in jnp.split(s_lat @ ada_w[i] + ada_b[i], N_MOD, axis=-1)]
        u = modulate(rmsnorm(h, norm_g[i, 0]), m_lat[0], m_lat[1])
        if ctx_in:
            m_ctx = jnp.split(s_ctx @ ada_w[i] + ada_b[i], N_MOD, axis=-1)
            uc = modulate(rmsnorm(hc, norm_g[i, 0]), m_ctx[0], m_ctx[1])
        else:
            uc = None
        if kind == 0:
            y, yc = window_gqa_mixer(u, uc, swa_w_qkv[j], swa_sink[j], swa_w_o[j], rope_swa, ctx_after)
        elif kind == 1:
            y, yc = mlstm_mixer(u, uc, ml_w_in[j], ml_gate_b[j], ml_head_g[j], ml_w_o[j], ctx_after)
        elif kind == 2:
            y, yc = mla_mixer(u, uc, mla_w_in[j], mla_q_g[j], mla_kv_g[j], mla_w_uq[j], mla_w_ukv[j], mla_w_o[j], rope_mla, ctx_after)
        else:
            y, yc = hyena_mixer(u, uc, hy_w_in[j], hy_conv_w[j], hy_conv_b[j], hy_f_w1[j], hy_f_b1[j],
                                hy_f_w2[j], hy_f_b2[j], hy_f_w3[j], hy_f_b3[j], hy_f_w4[j], hy_f_b4[j],
                                hy_f_freq[j], hy_decay[j], hy_skip[j], hy_w_o[j], ctx_after)
        h = h + m_lat[2] * rmsnorm(y, norm_g[i, 1])
        v = modulate(rmsnorm(h, norm_g[i, 2]), m_lat[3], m_lat[4])
        h = h + m_lat[5] * rmsnorm(sqrelu_mlp(v, mlp_w1[i], mlp_w2[i]), norm_g[i, 3])
        if ctx_after:
            hc = hc + m_ctx[2] * rmsnorm(yc, norm_g[i, 1])
            vc = modulate(rmsnorm(hc, norm_g[i, 2]), m_ctx[3], m_ctx[4])
            hc = hc + m_ctx[5] * rmsnorm(sqrelu_mlp(vc, mlp_w1[i], mlp_w2[i]), norm_g[i, 3])
    return h
```

```cpp
#include <hip/hip_runtime.h>
#include <stdint.h>
#include <stdio.h>

#ifndef MK_ONE_LAUNCH
#define MK_ONE_LAUNCH 0
#endif

typedef unsigned short bf16_t;
typedef short bf16x8 __attribute__((ext_vector_type(8)));
typedef short s16x4 __attribute__((ext_vector_type(4)));
typedef float f32x4 __attribute__((ext_vector_type(4)));
typedef float f32x2 __attribute__((ext_vector_type(2)));
typedef float f32x16 __attribute__((ext_vector_type(16)));
typedef unsigned u32x4 __attribute__((ext_vector_type(4)));
typedef unsigned u32x2 __attribute__((ext_vector_type(2)));
#define LAS __attribute__((address_space(3)))

constexpr int DM = 2048, NB = 4, SEQ = 4096, CTX = 256, FF = 8192;
constexpr int RL = NB * SEQ;
constexpr int RA = RL + NB * CTX;
constexpr int NMOD = 6 * DM;
constexpr float RMS_EPS = 1e-6f;
constexpr int NTHREADS = 512, NWAVES = 8;
constexpr int LDS_BYTES = 147456;
constexpr int LDS_MISC = LDS_BYTES - 256;

constexpr size_t al256(size_t x) { return (x + 255) & ~(size_t)255; }
constexpr size_t WS_CTL   = 0;
constexpr size_t WS_MODS  = 16384;
constexpr size_t WS_ROPEA = WS_MODS + al256((size_t)4 * 5 * NMOD * 4);
constexpr size_t WS_ROPEC = WS_ROPEA + (size_t)4096 * 64 * 8;
constexpr size_t WS_TW    = WS_ROPEC + (size_t)4096 * 32 * 8;
constexpr size_t WS_A3T   = WS_TW + (size_t)4096 * 8;
constexpr size_t WS_W1T   = WS_A3T + (size_t)64 * 4096 * 4;
constexpr size_t WS_W2T   = WS_W1T + (size_t)4 * FF * DM * 2;
constexpr size_t WS_QKVT  = WS_W2T + (size_t)4 * FF * DM * 2;
constexpr size_t WS_SWOT  = WS_QKVT + (size_t)3072 * DM * 2;
constexpr size_t WS_MLIN  = WS_SWOT + (size_t)DM * DM * 2;
constexpr size_t WS_MLO   = WS_MLIN + (size_t)6400 * DM * 2;
constexpr size_t WS_MAIN  = WS_MLO + (size_t)DM * DM * 2;
constexpr size_t WS_MUQ   = WS_MAIN + (size_t)1280 * DM * 2;
constexpr size_t WS_MUKV  = WS_MUQ + (size_t)3072 * 512 * 2;
constexpr size_t WS_MAO   = WS_MUKV + (size_t)4096 * 512 * 2;
constexpr size_t WS_HYIN  = WS_MAO + (size_t)DM * DM * 2;
constexpr size_t WS_HYO   = WS_HYIN + (size_t)6144 * DM * 2;
constexpr size_t WS_H     = WS_HYO + (size_t)DM * DM * 2;
constexpr size_t WS_U     = WS_H + (size_t)RA * DM * 4;
constexpr size_t WS_Y     = WS_U + (size_t)RA * DM * 2;
constexpr size_t WS_O     = WS_Y + (size_t)RA * DM * 4;
constexpr size_t WS_BIG   = WS_O + (size_t)RA * DM * 2;
constexpr size_t WS_T     = WS_BIG;
constexpr size_t WS_QKV   = WS_BIG;
constexpr size_t WS_Z1    = WS_BIG;
constexpr size_t WS_DC    = WS_Z1 + (size_t)RA * 6400 * 2;
constexpr size_t WS_DN    = WS_DC + (size_t)1088 * 32768 * 4;
constexpr size_t WS_AC    = WS_DN + (size_t)1088 * 128 * 4;
constexpr size_t WS_CS    = WS_AC + 8192;
constexpr size_t WS_NS    = WS_CS + (size_t)1088 * 32768 * 2;
constexpr size_t WS_HD    = WS_NS + (size_t)1088 * 128 * 4;
constexpr size_t WS_ML_END = WS_HD + (size_t)2 * RA * DM * 2;
constexpr size_t WS_Z2    = WS_BIG;
constexpr size_t WS_ZQ    = WS_Z2 + (size_t)RA * 1280 * 4;
constexpr size_t WS_ZKV   = WS_ZQ + (size_t)RA * 512 * 2;
constexpr size_t WS_KR    = WS_ZKV + (size_t)RA * 512 * 2;
constexpr size_t WS_Q2    = WS_KR + (size_t)RA * 64 * 2;
constexpr size_t WS_KV    = WS_Q2 + (size_t)RL * 3072 * 2;
constexpr size_t WS_ZT    = WS_BIG;
constexpr size_t WS_Y2T   = WS_ZT + (size_t)6144 * RL * 2;
constexpr size_t WS_Y1S   = WS_Y2T + (size_t)DM * RL * 2;
constexpr size_t WS_END   = WS_ML_END;

__device__ __forceinline__ unsigned cvt_pk_bf16(float lo, float hi) { unsigned r; asm volatile("v_cvt_pk_bf16_f32 %0, %1, %2" : "=v"(r) : "v"(lo), "v"(hi)); return r; }
__device__ __forceinline__ bf16_t f2bf(float x) { return (bf16_t)(cvt_pk_bf16(x, 0.f) & 0xffffu); }
__device__ __forceinline__ float bf2f(bf16_t b) { return __uint_as_float(((unsigned)b) << 16); }
__device__ __forceinline__ float bflo(unsigned w) { return __uint_as_float(w << 16); }
__device__ __forceinline__ float bfhi(unsigned w) { return __uint_as_float(w & 0xffff0000u); }
__device__ __forceinline__ int crow(int r, int hi) { return (r & 3) + 8 * (r >> 2) + 4 * hi; }
__device__ __forceinline__ float wave_sum(float v) {
#pragma unroll
    for (int o = 32; o >= 1; o >>= 1) v += __shfl_xor(v, o);
    return v;
}

#define XB_TMO      128
#define XB_XCNT(j)  (256  + 64 * (j))
#define XB_XSUB(j)  (1280 + 64 * (j))
#define XB_XGEN(j)  (2304 + 64 * (j))
#define XB_TOP      3328
#define XB_TOPGEN   3392
#define XCD_BAR_WORDS 3456
#define XB_SPIN_CAP (1u << 18)

__device__ __forceinline__ unsigned xb_ld(unsigned* p)              { return __hip_atomic_load(p, __ATOMIC_RELAXED, __HIP_MEMORY_SCOPE_AGENT); }
__device__ __forceinline__ unsigned xb_add(unsigned* p, unsigned v) { return __hip_atomic_fetch_add(p, v, __ATOMIC_RELAXED, __HIP_MEMORY_SCOPE_AGENT); }
__device__ __forceinline__ unsigned xb_xcc_id() { return (unsigned)__builtin_amdgcn_s_getreg((3 << 11) | 20) & 0xFu; }
#define XB_SPIN(cond, bar) do { unsigned _sp = 0; while (cond) { __builtin_amdgcn_s_sleep(1); \
    if ((++_sp & 255u) == 0u) { if (xb_ld(&(bar)[XB_TMO])) break; if (_sp > XB_SPIN_CAP) { atomicAdd(&(bar)[XB_TMO], 1u); break; } } } } while (0)

struct XcdBarrier {
    unsigned* bar; unsigned x;
    volatile LAS unsigned* st;
};

__device__ __forceinline__ XcdBarrier xcd_barrier_post(unsigned* bar, volatile LAS unsigned* st) {
    XcdBarrier b; b.bar = bar; b.x = xb_xcc_id(); b.st = st;
    if (threadIdx.x == 0) (void)xb_add(&bar[XB_XCNT(b.x)], 1u);
    return b;
}
__device__ __forceinline__ void xcd_barrier_complete(unsigned* bar, unsigned x, unsigned& nloc, unsigned& nx) {
    const unsigned G = gridDim.x * gridDim.y * gridDim.z;
    unsigned sum, cnt, mine, sp = 0u;
    for (;;) {
        sum = 0u; cnt = 0u; mine = 0u;
#pragma unroll
        for (unsigned j = 0; j < 16; ++j) { const unsigned c = xb_ld(&bar[XB_XCNT(j)]); sum += c; cnt += (c > 0u) ? 1u : 0u; mine = (j == x) ? c : mine; }
        if (sum == G) break;
        __builtin_amdgcn_s_sleep(1);
        if ((++sp & 255u) == 0u) { if (xb_ld(&bar[XB_TMO])) break; if (sp > XB_SPIN_CAP) { atomicAdd(&bar[XB_TMO], 1u); break; } }
    }
    nloc = mine > 0u ? mine : 1u; nx = cnt > 0u ? cnt : 1u;
}

__device__ __forceinline__ void xcd_barrier(const XcdBarrier& b) {
    asm volatile("s_waitcnt vmcnt(0)" ::: "memory");
    __syncthreads();
    if (threadIdx.x == 0) {
        unsigned* bar = b.bar;
        __builtin_amdgcn_s_waitcnt(0);
        unsigned nloc = b.st[0], nx = b.st[1];
        if (nloc == 0u) { xcd_barrier_complete(bar, b.x, nloc, nx); b.st[0] = nloc; b.st[1] = nx; }
        const unsigned old = xb_add(&bar[XB_XSUB(b.x)], 1u);
        const unsigned gen = old / nloc;
        if (old + 1u == (gen + 1u) * nloc) {
            __builtin_amdgcn_fence(__ATOMIC_RELEASE, "agent");
            asm volatile("s_waitcnt vmcnt(0)" ::: "memory");
            const unsigned og = xb_add(&bar[XB_TOP], 1u);
            const unsigned tg = og / nx;
            if (og + 1u == (tg + 1u) * nx) xb_add(&bar[XB_TOPGEN], 1u);
            else XB_SPIN(xb_ld(&bar[XB_TOPGEN]) == tg, bar);
            __builtin_amdgcn_fence(__ATOMIC_ACQUIRE, "agent");
            xb_add(&bar[XB_XGEN(b.x)], 1u);
            asm volatile("s_waitcnt vmcnt(0)" ::: "memory");
        } else {
            XB_SPIN(xb_ld(&bar[XB_XGEN(b.x)]) == gen, bar);
            __builtin_amdgcn_fence(__ATOMIC_ACQUIRE, "agent");
            asm volatile("s_waitcnt vmcnt(0)" ::: "memory");
        }
    }
    __syncthreads();
}

namespace pg8 {
#define PG8_LAS __attribute__((address_space(3)))
typedef unsigned short bf16_t;
typedef short bf16x8 __attribute__((ext_vector_type(8)));
typedef float f32x4 __attribute__((ext_vector_type(4)));
typedef unsigned u32x4 __attribute__((ext_vector_type(4)));
constexpr int BM = 256, BK = 64, HALF = 128, HTB = HALF * BK * 2  , STAGE_BYTES = 8 * HTB, NXCD = 8, WGM = 8;

__host__ __device__ __forceinline__ int lds_byte(int r, int c) { const int st = (r >> 4) * 2 + (c >> 5), rr = r & 15, cc = c & 31, ob = rr * 64 + cc * 2; return st * 1024 + (ob ^ (((ob >> 9) & 1) << 5)); }
__host__ __device__ __forceinline__ void stage_rc(int b, int& R, int& C) { const int st = b / 1024, sb = b % 1024, swz = sb ^ (((sb >> 9) & 1) << 5); R = (st >> 1) * 16 + swz / 64; C = (st & 1) * 32 + (swz % 64) / 2; }
__host__ __device__ __forceinline__ int perm32(int rho) { const int n = rho >> 4, i = rho & 15; return 8 * (i >> 2) + 4 * n + (i & 3); }

struct Unit { int pm, pn; };
struct Gemm { const bf16_t* A; const bf16_t* Bt; int M, N, K; };

struct StaticOrder {
    int nM, nN, nwg, G, c;
    __host__ __device__ void init(int M, int N, int G_, int c_) { nM = M / BM; nN = N / BM; nwg = nM * nN; G = G_; c = c_; }
    __host__ __device__ bool next(int i, Unit& u) const {
        const long L = (long)i * G + c; if (L >= nwg) return false;
        int wgid = (int)L; { const int q = nwg / NXCD, r = nwg % NXCD, xcd = wgid % NXCD, off = wgid / NXCD; wgid = (xcd < r ? xcd * (q + 1) : r * (q + 1) + (xcd - r) * q) + off; }
        const int nig = WGM * nN, gid = wgid / nig, fm = gid * WGM, gsz = (nM - fm) < WGM ? (nM - fm) : WGM;
        u.pm = fm + ((wgid % nig) % gsz); u.pn = (wgid % nig) / gsz; return true;
    }
    __device__ __forceinline__ void a_ready(const Unit&) const {}
    __device__ __forceinline__ void done(const Unit&) const {}
};
__device__ __forceinline__ unsigned cvt_pk_bf16(float lo, float hi) { unsigned r; asm volatile("v_cvt_pk_bf16_f32 %0, %1, %2" : "=v"(r) : "v"(lo), "v"(hi)); return r; }

template <class Epi, class Sched, bool STAMP = false>
__device__ __forceinline__ void gemm_phase(PG8_LAS unsigned char* lds, const Gemm g, const Sched& S, const Epi& E, unsigned long long* stamps) {
    const int tid = threadIdx.x, wid = __builtin_amdgcn_readfirstlane(tid >> 6), lane = tid & 63, wr = wid >> 2, wc = wid & 3, fr = lane & 15, fq = lane >> 4;
    const int K = g.K, nt = K / BK;
    int ts_lo = 0, ts_hi = 0, nts = 0; const unsigned long long rt_entry = STAMP ? (unsigned long long)wall_clock64() : 0ull;
#define PG8_STAMP() do { if (STAMP && wid == 0 && nts < 64) { const unsigned long long _c = (unsigned long long)clock64(); \
        ts_lo = (lane == nts) ? (int)(unsigned)_c : ts_lo; ts_hi = (lane == nts) ? (int)(unsigned)(_c >> 32) : ts_hi; ++nts; } } while (0)
    PG8_STAMP();
    unsigned voffA[2], voffB[2];
#pragma unroll
    for (int i = 0; i < 2; ++i) { int R, C; stage_rc(tid * 16 + i * 8192, R, C); const int Rb = Epi::PERM ? ((R & ~31) + perm32(R & 31)) : R;
        voffA[i] = (unsigned)(R * K + C) * 2u; voffB[i] = (unsigned)(Rb * K + C) * 2u; }
    const size_t kstep = (size_t)(BK * 2);
    const size_t hstep = (size_t)HALF * K * 2;
    const size_t tstep = 2 * hstep;
    const unsigned ldsw = (unsigned)wid * 1024u;
    const int aoff = lds_byte(wr * 64 + fr, fq * 8), boff = lds_byte(wc * 32 + fr, fq * 8);
#define PG8_SA(b, h) (((b) * 2 + (h)) * HTB)
#define PG8_SB(b, h) ((4 + (b) * 2 + (h)) * HTB)
#define PG8_STAGE(bufoff, gbase, voff) do { _Pragma("unroll") for (int _i = 0; _i < 2; ++_i) \
        __builtin_amdgcn_global_load_lds((const unsigned*)((const char*)(gbase) + (voff)[_i]), (PG8_LAS unsigned*)(lds + (bufoff) + ldsw + _i * 8192), 16, 0, 0); } while (0)
#define PG8_LDA(dst, b, h) do { _Pragma("unroll") for (int m = 0; m < 4; ++m) _Pragma("unroll") for (int k = 0; k < 2; ++k) dst[m][k] = *(const PG8_LAS bf16x8*)(lds + PG8_SA(b, h) + aoff + m * 2048 + k * 1024); } while (0)
#define PG8_LDB(dst, b, h) do { _Pragma("unroll") for (int n = 0; n < 2; ++n) _Pragma("unroll") for (int k = 0; k < 2; ++k) dst[n][k] = *(const PG8_LAS bf16x8*)(lds + PG8_SB(b, h) + boff + n * 2048 + k * 1024); } while (0)
#define PG8_MMA(ai, bj, At, Bt) do { __builtin_amdgcn_s_setprio(1); _Pragma("unroll") for (int m = 0; m < 4; ++m) _Pragma("unroll") for (int n = 0; n < 2; ++n) _Pragma("unroll") for (int k = 0; k < 2; ++k) \
        acc[ai][bj][m][n] = __builtin_amdgcn_mfma_f32_16x16x32_bf16(Bt[n][k], At[m][k], acc[ai][bj][m][n], 0, 0, 0); __builtin_amdgcn_s_setprio(0); } while (0)
#define PG8_WAIT_V(n) asm volatile("s_waitcnt vmcnt(" #n ")" ::: "memory")
#define PG8_WAIT_L(n) asm volatile("s_waitcnt lgkmcnt(" #n ")" ::: "memory")
#define PG8_BAR __builtin_amdgcn_s_barrier()
#define PG8_SCHED __builtin_amdgcn_sched_barrier(0)
    Unit cur, nxt; int ui = 0;
    if (!S.next(0, cur)) return;
    f32x4 acc[2][2][4][2];
#pragma unroll
    for (int a = 0; a < 2; ++a)
#pragma unroll
        for (int b = 0; b < 2; ++b)
#pragma unroll
            for (int m = 0; m < 4; ++m)
#pragma unroll
                for (int n = 0; n < 2; ++n) acc[a][b][m][n] = (f32x4){0.f, 0.f, 0.f, 0.f};
    bf16x8 At[4][2], B0[2][2], B1[2][2];
    const char* cA = (const char*)g.A + (size_t)cur.pm * tstep; const char* cB = (const char*)g.Bt + (size_t)cur.pn * tstep;
    S.a_ready(cur);
    PG8_STAGE(PG8_SB(0, 0), cB, voffB); PG8_STAGE(PG8_SA(0, 0), cA, voffA); PG8_STAGE(PG8_SB(0, 1), cB + hstep, voffB); PG8_STAGE(PG8_SA(0, 1), cA + hstep, voffA);
    if (wr == 1) PG8_BAR;
    PG8_WAIT_V(4); PG8_BAR;
    PG8_STAGE(PG8_SB(1, 0), cB + kstep, voffB); PG8_STAGE(PG8_SA(1, 0), cA + kstep, voffA); PG8_STAGE(PG8_SB(1, 1), cB + hstep + kstep, voffB);
    PG8_WAIT_V(6); PG8_BAR;
    PG8_STAMP();
    for (;;) {
        const bool has_next = S.next(ui + 1, nxt);
        const char* nA = has_next ? (const char*)g.A + (size_t)nxt.pm * tstep : cA; const char* nB = has_next ? (const char*)g.Bt + (size_t)nxt.pn * tstep : cB;
        for (int t = 0; t < nt; t += 2) {
            const bool last = (t == nt - 2);
            const char* a1 = cA + (size_t)(t + 1) * kstep;
            const char* a2 = last ? nA : cA + (size_t)(t + 2) * kstep; const char* b2 = last ? nB : cB + (size_t)(t + 2) * kstep;
            const char* a3 = a2 + kstep; const char* b3 = b2 + kstep;
            if (last && has_next) S.a_ready(nxt);
            PG8_LDB(B0, 0, 0); PG8_SCHED; PG8_LDA(At, 0, 0); PG8_STAGE(PG8_SA(1, 1), a1 + hstep, voffA);
            PG8_WAIT_L(8); PG8_BAR; PG8_WAIT_L(0); PG8_MMA(0, 0, At, B0); PG8_BAR; PG8_SCHED;
            PG8_LDB(B1, 0, 1); PG8_STAGE(PG8_SB(0, 0), b2, voffB);
            PG8_BAR; PG8_WAIT_L(0); PG8_MMA(0, 1, At, B1); PG8_BAR;
            PG8_LDA(At, 0, 1); PG8_STAGE(PG8_SA(0, 0), a2, voffA);
            PG8_BAR; PG8_WAIT_L(0); PG8_MMA(1, 0, At, B0); PG8_BAR; PG8_SCHED;
            PG8_STAGE(PG8_SB(0, 1), b2 + hstep, voffB);
            PG8_WAIT_V(6); PG8_BAR; PG8_MMA(1, 1, At, B1); PG8_BAR;
            PG8_LDB(B0, 1, 0); PG8_SCHED; PG8_LDA(At, 1, 0); PG8_STAGE(PG8_SA(0, 1), a2 + hstep, voffA);
            PG8_WAIT_L(8); PG8_BAR; PG8_WAIT_L(0); PG8_MMA(0, 0, At, B0); PG8_BAR; PG8_SCHED;
            PG8_LDB(B1, 1, 1); PG8_STAGE(PG8_SB(1, 0), b3, voffB);
            PG8_BAR; PG8_WAIT_L(0); PG8_MMA(0, 1, At, B1); PG8_BAR;
            PG8_LDA(At, 1, 1); PG8_STAGE(PG8_SA(1, 0), a3, voffA);
            PG8_BAR; PG8_WAIT_L(0); PG8_MMA(1, 0, At, B0); PG8_BAR; PG8_SCHED;
            PG8_STAGE(PG8_SB(1, 1), b3 + hstep, voffB);
            PG8_WAIT_V(6); PG8_BAR; PG8_MMA(1, 1, At, B1); PG8_BAR;
        }
        PG8_STAMP();
        if constexpr (!Epi::AFTER_DRAIN) { E(acc, cur, wr, wc, fr, fq); S.done(cur); }
        PG8_STAMP();
        if (!has_next) break;
#pragma unroll
        for (int a = 0; a < 2; ++a)
#pragma unroll
            for (int b = 0; b < 2; ++b)
#pragma unroll
                for (int m = 0; m < 4; ++m)
#pragma unroll
                    for (int n = 0; n < 2; ++n) acc[a][b][m][n] = (f32x4){0.f, 0.f, 0.f, 0.f};
        cur = nxt; cA = nA; cB = nB; ++ui;
    }
    PG8_WAIT_V(0);
    if (wr == 0) PG8_BAR;
    PG8_BAR;
    if constexpr (Epi::AFTER_DRAIN) { E.fused(acc, cur, wr, wc, fr, fq, lds, wid, lane); S.done(cur); }
    PG8_STAMP();
    if (STAMP && wid == 0) { stamps[lane] = lane < nts ? (((unsigned long long)(unsigned)ts_hi << 32) | (unsigned)ts_lo) : 0ull;
        if (lane == 62) stamps[62] = rt_entry; if (lane == 63) stamps[63] = (unsigned long long)wall_clock64(); }
#undef PG8_STAMP
#undef PG8_SA
#undef PG8_SB
#undef PG8_STAGE
#undef PG8_LDA
#undef PG8_LDB
#undef PG8_MMA
#undef PG8_WAIT_V
#undef PG8_WAIT_L
#undef PG8_BAR
#undef PG8_SCHED
}
}

template <int MODE> struct EpiG {
    static constexpr bool PERM = true, AFTER_DRAIN = false;
    void* out; int ldc;
    const f32x2* rope; int head_w, rope_off, rope_cols, tab_stride, rope_rows;
    __device__ __forceinline__ void operator()(const pg8::f32x4 (&acc)[2][2][4][2], const pg8::Unit& u, int wr, int wc, int fr, int fq) const {
        const int row0 = u.pm * 256 + wr * 64 + fr, col0 = u.pn * 256 + wc * 32 + 8 * fq;
#pragma unroll
        for (int ai = 0; ai < 2; ++ai)
#pragma unroll
            for (int m = 0; m < 4; ++m) {
                const int row = row0 + ai * 128 + m * 16;
#pragma unroll
                for (int bj = 0; bj < 2; ++bj) {
                    const int col = col0 + bj * 128;
                    f32x4 v0 = acc[ai][bj][m][0], v1 = acc[ai][bj][m][1];
                    if (MODE == 0) {
                        if (rope != nullptr && col < rope_cols && row < rope_rows) {
                            const int hc = col % head_w;
                            if (hc >= rope_off) {
                                const f32x2* tab = rope + (size_t)(row & 4095) * tab_stride + ((hc - rope_off) >> 1);
                                const f32x2 c0 = tab[0], c1 = tab[1], c2 = tab[2], c3 = tab[3];
                                f32x4 w0, w1;
                                w0[0] = v0[0] * c0.x - v0[1] * c0.y; w0[1] = v0[1] * c0.x + v0[0] * c0.y;
                                w0[2] = v0[2] * c1.x - v0[3] * c1.y; w0[3] = v0[3] * c1.x + v0[2] * c1.y;
                                w1[0] = v1[0] * c2.x - v1[1] * c2.y; w1[1] = v1[1] * c2.x + v1[0] * c2.y;
                                w1[2] = v1[2] * c3.x - v1[3] * c3.y; w1[3] = v1[3] * c3.x + v1[2] * c3.y;
                                v0 = w0; v1 = w1;
                            }
                        }
                    }
                    if (MODE == 1) {
#pragma unroll
                        for (int j = 0; j < 4; ++j) { float a = fmaxf(v0[j], 0.f), b = fmaxf(v1[j], 0.f); v0[j] = a * a; v1[j] = b * b; }
                    }
                    if (MODE == 2) {
                        float* rp = (float*)out + (size_t)row * ldc + col;
                        *(f32x4*)rp = v0; *(f32x4*)(rp + 4) = v1;
                    } else {
                        u32x4 w; w.x = cvt_pk_bf16(v0[0], v0[1]); w.y = cvt_pk_bf16(v0[2], v0[3]); w.z = cvt_pk_bf16(v1[0], v1[1]); w.w = cvt_pk_bf16(v1[2], v1[3]);
                        *(u32x4*)((bf16_t*)out + (size_t)row * ldc + col) = w;
                    }
                }
            }
    }
};
template <int MODE> __device__ __forceinline__ void run_gemm(LAS unsigned char* lds, const bf16_t* A, const bf16_t* Bt, int M, int N, int K, const EpiG<MODE>& E) {
    pg8::Gemm g{A, Bt, M, N, K};
    pg8::StaticOrder S; S.init(M, N, (int)gridDim.x, (int)blockIdx.x);
    pg8::gemm_phase<EpiG<MODE>, pg8::StaticOrder, false>((PG8_LAS unsigned char*)lds, g, S, E, nullptr);
}
template <int MODE> __device__ __forceinline__ EpiG<MODE> mk_epi(void* out, int ldc) { EpiG<MODE> e; e.out = out; e.ldc = ldc; e.rope = nullptr; e.head_w = 128; e.rope_off = 0; e.rope_cols = 0; e.tab_stride = 0; e.rope_rows = 0; return e; }

__device__ __forceinline__ int wmap(int kind, int n, int Nsrc) {
    if (kind == 1) {
        if (n < 2560) { const int hb = n & ~127, j = n & 127; return hb + ((j & 1) ? 64 : 0) + (j >> 1); }
        return n;
    }
    if (kind == 2) {
        if (n < 1024) return n;
        if (n < 1088) { const int j = n - 1024; return 1024 + ((j & 1) ? 32 : 0) + (j >> 1); }
        return -1;
    }
    if (kind == 3) {
        const int hd = n / 192, j = n - hd * 192;
        if (j < 128) return n;
        const int jj = j - 128; return hd * 192 + 128 + ((jj & 1) ? 32 : 0) + (jj >> 1);
    }
    return n < Nsrc ? n : -1;
}
__device__ __forceinline__ void conv_weight(LAS unsigned char* lds, const float* __restrict__ src, bf16_t* __restrict__ dst, int K, int Nsrc, int Ndst, int kind, int nscale, float scale) {
    LAS float* tile = (LAS float*)lds;
    const int tid = threadIdx.x, tilesN = Ndst / 64, tilesK = K / 64, ntile = tilesN * tilesK;
    for (int t = blockIdx.x; t < ntile; t += gridDim.x) {
        const int tn = t % tilesN, tk = t / tilesN;
        const int j = tid & 63, n = tn * 64 + j, sc = wmap(kind, n, Nsrc);
        const float mul = (n < nscale) ? scale : 1.f;
#pragma unroll
        for (int p = 0; p < 8; ++p) {
            const int i = p * 8 + (tid >> 6);
            float v = 0.f;
            if (sc >= 0) v = src[(size_t)(tk * 64 + i) * Nsrc + sc] * mul;
            tile[i * 65 + j] = v;
        }
        __syncthreads();
        {
            const int nn = tid >> 3, kg = tid & 7;
            float f[8];
#pragma unroll
            for (int q = 0; q < 8; ++q) f[q] = tile[(kg * 8 + q) * 65 + nn];
            u32x4 w; w.x = cvt_pk_bf16(f[0], f[1]); w.y = cvt_pk_bf16(f[2], f[3]); w.z = cvt_pk_bf16(f[4], f[5]); w.w = cvt_pk_bf16(f[6], f[7]);
            *(u32x4*)(dst + (size_t)(tn * 64 + nn) * K + tk * 64 + kg * 8) = w;
        }
        __syncthreads();
    }
}

__device__ __forceinline__ float silu_f(float x) { return x / (1.f + __expf(-x)); }

__device__ __forceinline__ void ph_mods(LAS unsigned char* lds, const float* __restrict__ c, const float* __restrict__ c_ctx, const float* __restrict__ ada_w, const float* __restrict__ ada_b, float* __restrict__ mods) {
    LAS float* s = (LAS float*)lds;
    LAS float* red = (LAS float*)(lds + 5 * 2048 * 4);
    const int tid = threadIdx.x;
    for (int i = tid; i < 5 * 2048; i += NTHREADS) { const int m = i >> 11, k = i & 2047; s[i] = silu_f(m < 4 ? c[m * 2048 + k] : c_ctx[k]); }
    __syncthreads();
    const int cl = tid & 127, ks = tid >> 7;
    for (int u = blockIdx.x; u < 4 * 96; u += gridDim.x) {
        const int layer = u / 96, cg = u % 96, col = cg * 128 + cl;
        const float* wp = ada_w + ((size_t)layer * 2048 + ks * 512) * NMOD + col;
        float a0 = 0.f, a1 = 0.f, a2 = 0.f, a3 = 0.f, a4 = 0.f;
#pragma unroll 8
        for (int k = 0; k < 512; ++k) {
            const float w = wp[(size_t)k * NMOD];
            const int kk = ks * 512 + k;
            a0 += s[kk] * w; a1 += s[2048 + kk] * w; a2 += s[4096 + kk] * w; a3 += s[6144 + kk] * w; a4 += s[8192 + kk] * w;
        }
        red[(ks * 5 + 0) * 128 + cl] = a0; red[(ks * 5 + 1) * 128 + cl] = a1; red[(ks * 5 + 2) * 128 + cl] = a2; red[(ks * 5 + 3) * 128 + cl] = a3; red[(ks * 5 + 4) * 128 + cl] = a4;
        __syncthreads();
        for (int i = tid; i < 5 * 128; i += NTHREADS) {
            const int m = i >> 7, cc = i & 127;
            const float v = red[(0 * 5 + m) * 128 + cc] + red[(1 * 5 + m) * 128 + cc] + red[(2 * 5 + m) * 128 + cc] + red[(3 * 5 + m) * 128 + cc];
            mods[((size_t)layer * 5 + m) * NMOD + cg * 128 + cc] = v + ada_b[(size_t)layer * NMOD + cg * 128 + cc];
        }
        __syncthreads();
    }
}

__device__ __forceinline__ void ph_tables(f32x2* __restrict__ ropeA, f32x2* __restrict__ ropeC, f32x2* __restrict__ tw) {
    const int gt = blockIdx.x * NTHREADS + threadIdx.x, gn = gridDim.x * NTHREADS;
    for (int i = gt; i < 4096 * 64; i += gn) {
        const int t = i >> 6, p = i & 63, j = p & 31;
        const float inv = powf(10000.0f, -(float)j / 32.0f);
        const float pos = (float)((p < 32) ? (t >> 6) : (t & 63));
        const float ang = pos * inv;
        f32x2 v; v.x = cosf(ang); v.y = sinf(ang); ropeA[i] = v;
    }
    for (int i = gt; i < 4096 * 32; i += gn) {
        const int t = i >> 5, p = i & 31, j = p & 15;
        const float inv = powf(10000.0f, -(float)j / 16.0f);
        const float pos = (float)((p < 16) ? (t >> 6) : (t & 63));
        const float ang = pos * inv;
        f32x2 v; v.x = cosf(ang); v.y = sinf(ang); ropeC[i] = v;
    }
    for (int i = gt; i < 4096; i += gn) {
        float sn, cs; sincospif((float)i / 4096.0f, &sn, &cs);
        f32x2 v; v.x = cs; v.y = -sn; tw[i] = v;
    }
}

__device__ __forceinline__ void ph_hyena_feats(LAS unsigned char* lds, const float* __restrict__ w1, const float* __restrict__ b1, const float* __restrict__ w2, const float* __restrict__ b2,
                                               const float* __restrict__ w3, const float* __restrict__ b3, const float* __restrict__ freq, float* __restrict__ a3T) {
    const int tid = threadIdx.x, wave = tid >> 6, lane = tid & 63;
    LAS float* fa = (LAS float*)lds + wave * 128;
    LAS float* fb = fa + 64;
    const float fr = freq[lane];
    for (int l0 = blockIdx.x * 8; l0 < 4096; l0 += gridDim.x * 8) {
        const int l = l0 + wave;
        const float w = (6.283185307179586f / 4096.0f) * (float)l;
        float f = 0.f;
        if (lane == 0) f = (float)l * (1.0f / 4095.0f);
        else if (lane <= 32) {
            const int j = (lane - 1) & 15;
            const float band = 1e-4f + (float)j * ((15.0f - 1e-4f) / 15.0f);
            f = (lane <= 16) ? cosf(band * w) : -sinf(band * w);
        }
        __syncthreads();
        fa[lane] = f;
        __syncthreads();
        float acc = b1[lane];
        for (int i = 0; i < 33; ++i) acc += fa[i] * w1[i * 64 + lane];
        fb[lane] = sinf(fr * acc);
        __syncthreads();
        acc = b2[lane];
        for (int i = 0; i < 64; ++i) acc += fb[i] * w2[i * 64 + lane];
        fa[lane] = sinf(fr * acc);
        __syncthreads();
        acc = b3[lane];
        for (int i = 0; i < 64; ++i) acc += fa[i] * w3[i * 64 + lane];
        a3T[(size_t)lane * 4096 + l] = sinf(fr * acc);
    }
}

__device__ __forceinline__ void ph_normmod(const float* __restrict__ xin, const float* __restrict__ cin, const float* __restrict__ h, bool from_input,
                                           const float* __restrict__ g, const float* __restrict__ mods, int kshift, int kscale, bf16_t* __restrict__ out, int nrows) {
    const int lane = threadIdx.x & 63, gw = blockIdx.x * NWAVES + (threadIdx.x >> 6), nw = gridDim.x * NWAVES;
    for (int r = gw; r < nrows; r += nw) {
        const float* src = from_input ? (r < RL ? xin + (size_t)r * DM : cin + (size_t)(r - RL) * DM) : h + (size_t)r * DM;
        const int b = r < RL ? (r >> 12) : 4;
        const float* sh = mods + (size_t)b * NMOD + kshift * DM;
        const float* sc = mods + (size_t)b * NMOD + kscale * DM;
        f32x4 v[8]; float ss = 0.f;
#pragma unroll
        for (int j = 0; j < 8; ++j) { v[j] = *(const f32x4*)(src + j * 256 + lane * 4); ss += v[j][0] * v[j][0] + v[j][1] * v[j][1] + v[j][2] * v[j][2] + v[j][3] * v[j][3]; }
        ss = wave_sum(ss);
        const float rstd = rsqrtf(ss * (1.0f / DM) + RMS_EPS);
#pragma unroll
        for (int j = 0; j < 8; ++j) {
            const int col = j * 256 + lane * 4;
            const f32x4 gg = *(const f32x4*)(g + col), s1 = *(const f32x4*)(sh + col), s2 = *(const f32x4*)(sc + col);
            f32x4 o;
#pragma unroll
            for (int e = 0; e < 4; ++e) o[e] = (v[j][e] * rstd * gg[e]) * (1.f + s2[e]) + s1[e];
            u32x2 w; w.x = cvt_pk_bf16(o[0], o[1]); w.y = cvt_pk_bf16(o[2], o[3]);
            *(u32x2*)(out + (size_t)r * DM + col) = w;
        }
    }
}

__device__ __forceinline__ void ph_resid(const float* __restrict__ y, const float* __restrict__ gy, const float* __restrict__ mods, int kgate,
                                         const float* __restrict__ xin, const float* __restrict__ cin, const float* __restrict__ h, bool from_input,
                                         float* __restrict__ hdst, bool do_norm, const float* __restrict__ g2, const float* __restrict__ mods2, int kshift, int kscale,
                                         bf16_t* __restrict__ uout, int nrows) {
    const int lane = threadIdx.x & 63, gw = blockIdx.x * NWAVES + (threadIdx.x >> 6), nw = gridDim.x * NWAVES;
    for (int r = gw; r < nrows; r += nw) {
        const float* src = from_input ? (r < RL ? xin + (size_t)r * DM : cin + (size_t)(r - RL) * DM) : h + (size_t)r * DM;
        const int b = r < RL ? (r >> 12) : 4;
        const float* gt = mods + (size_t)b * NMOD + kgate * DM;
        const float* yr = y + (size_t)r * DM;
        f32x4 v[8]; float ss = 0.f;
#pragma unroll
        for (int j = 0; j < 8; ++j) { v[j] = *(const f32x4*)(yr + j * 256 + lane * 4); ss += v[j][0] * v[j][0] + v[j][1] * v[j][1] + v[j][2] * v[j][2] + v[j][3] * v[j][3]; }
        ss = wave_sum(ss);
        const float rstd = rsqrtf(ss * (1.0f / DM) + RMS_EPS);
        float ss2 = 0.f;
#pragma unroll
        for (int j = 0; j < 8; ++j) {
            const int col = j * 256 + lane * 4;
            const f32x4 gg = *(const f32x4*)(gy + col), ga = *(const f32x4*)(gt + col), hv = *(const f32x4*)(src + col);
            f32x4 o;
#pragma unroll
            for (int e = 0; e < 4; ++e) { o[e] = hv[e] + ga[e] * (v[j][e] * rstd * gg[e]); ss2 += o[e] * o[e]; }
            *(f32x4*)(hdst + (size_t)r * DM + col) = o;
            v[j] = o;
        }
        if (do_norm) {
            ss2 = wave_sum(ss2);
            const float rstd2 = rsqrtf(ss2 * (1.0f / DM) + RMS_EPS);
            const float* sh = mods2 + (size_t)b * NMOD + kshift * DM;
            const float* sc = mods2 + (size_t)b * NMOD + kscale * DM;
#pragma unroll
            for (int j = 0; j < 8; ++j) {
                const int col = j * 256 + lane * 4;
                const f32x4 gg = *(const f32x4*)(g2 + col), s1 = *(const f32x4*)(sh + col), s2 = *(const f32x4*)(sc + col);
                f32x4 o;
#pragma unroll
                for (int e = 0; e < 4; ++e) o[e] = (v[j][e] * rstd2 * gg[e]) * (1.f + s2[e]) + s1[e];
                u32x2 w; w.x = cvt_pk_bf16(o[0], o[1]); w.y = cvt_pk_bf16(o[2], o[3]);
                *(u32x2*)(uout + (size_t)r * DM + col) = w;
            }
        }
    }
}

__device__ __forceinline__ void ph_mla_rows(const float* __restrict__ z, const float* __restrict__ qg, const float* __restrict__ kvg, const f32x2* __restrict__ ropeC,
                                            bf16_t* __restrict__ zq, bf16_t* __restrict__ zkv, bf16_t* __restrict__ kr) {
    const int lane = threadIdx.x & 63, gw = blockIdx.x * NWAVES + (threadIdx.x >> 6), nw = gridDim.x * NWAVES;
    for (int r = gw; r < RA; r += nw) {
        const float* zr = z + (size_t)r * 1280;
#pragma unroll
        for (int part = 0; part < 2; ++part) {
            const float* p = zr + part * 512 + lane * 8;
            const f32x4 a = *(const f32x4*)p, b = *(const f32x4*)(p + 4);
            float ss = a[0] * a[0] + a[1] * a[1] + a[2] * a[2] + a[3] * a[3] + b[0] * b[0] + b[1] * b[1] + b[2] * b[2] + b[3] * b[3];
            ss = wave_sum(ss);
            const float rstd = rsqrtf(ss * (1.0f / 512.0f) + RMS_EPS);
            const float* gp = (part ? kvg : qg) + lane * 8;
            const f32x4 g0 = *(const f32x4*)gp, g1 = *(const f32x4*)(gp + 4);
            u32x4 w; w.x = cvt_pk_bf16(a[0] * rstd * g0[0], a[1] * rstd * g0[1]); w.y = cvt_pk_bf16(a[2] * rstd * g0[2], a[3] * rstd * g0[3]);
            w.z = cvt_pk_bf16(b[0] * rstd * g1[0], b[1] * rstd * g1[1]); w.w = cvt_pk_bf16(b[2] * rstd * g1[2], b[3] * rstd * g1[3]);
            *(u32x4*)((part ? zkv : zq) + (size_t)r * 512 + lane * 8) = w;
        }
        const float x = zr[1024 + lane];
        const float xp = __shfl_xor(x, 1);
        float o = x;
        if (r < RL) {
            const f32x2 cs = ropeC[(size_t)(r & 4095) * 32 + (lane >> 1)];
            o = (lane & 1) ? (x * cs.x + xp * cs.y) : (x * cs.x - xp * cs.y);
        }
        kr[(size_t)r * 64 + lane] = f2bf(o);
    }
}

__device__ __forceinline__ void ph_headnorm(const bf16_t* __restrict__ hf, const bf16_t* __restrict__ hb, const bf16_t* __restrict__ z1, const float* __restrict__ head_g, bf16_t* __restrict__ out) {
    const int lane = threadIdx.x & 63, gw = blockIdx.x * NWAVES + (threadIdx.x >> 6), nw = gridDim.x * NWAVES;
    for (int r = gw; r < RA; r += nw) {
        float v[32]; float ss = 0.f;
#pragma unroll
        for (int q = 0; q < 4; ++q) {
            const u32x4 a = *(const u32x4*)(hf + (size_t)r * DM + lane * 32 + q * 8), b = *(const u32x4*)(hb + (size_t)r * DM + lane * 32 + q * 8);
#pragma unroll
            for (int e = 0; e < 4; ++e) { v[q * 8 + 2 * e] = bflo(a[e]) + bflo(b[e]); v[q * 8 + 2 * e + 1] = bfhi(a[e]) + bfhi(b[e]); }
        }
#pragma unroll
        for (int e = 0; e < 32; ++e) ss += v[e] * v[e];
        ss += __shfl_xor(ss, 1); ss += __shfl_xor(ss, 2); ss += __shfl_xor(ss, 4);
        const float rstd = rsqrtf(ss * (1.0f / 256.0f) + RMS_EPS);
#pragma unroll
        for (int q = 0; q < 4; ++q) {
            const u32x4 og = *(const u32x4*)(z1 + (size_t)r * 6400 + 4096 + lane * 32 + q * 8);
            const f32x4 g0 = *(const f32x4*)(head_g + lane * 32 + q * 8), g1 = *(const f32x4*)(head_g + lane * 32 + q * 8 + 4);
            float o[8];
#pragma unroll
            for (int e = 0; e < 4; ++e) {
                const float ga = 1.f / (1.f + __expf(-bflo(og[e]))), gb = 1.f / (1.f + __expf(-bfhi(og[e])));
                const float gg0 = (e < 2) ? g0[2 * e] : g1[2 * e - 4], gg1 = (e < 2) ? g0[2 * e + 1] : g1[2 * e - 3];
                o[2 * e] = v[q * 8 + 2 * e] * rstd * gg0 * ga; o[2 * e + 1] = v[q * 8 + 2 * e + 1] * rstd * gg1 * gb;
            }
            u32x4 w; w.x = cvt_pk_bf16(o[0], o[1]); w.y = cvt_pk_bf16(o[2], o[3]); w.z = cvt_pk_bf16(o[4], o[5]); w.w = cvt_pk_bf16(o[6], o[7]);
            *(u32x4*)(out + (size_t)r * DM + lane * 32 + q * 8) = w;
        }
    }
}

__device__ __forceinline__ void ph_transpose(LAS unsigned char* lds, const bf16_t* __restrict__ src, bf16_t* __restrict__ dst) {
    LAS bf16_t* tile = (LAS bf16_t*)lds;
    const int tid = threadIdx.x;
    const int ntile = (DM / 64) * (RL / 64);
    for (int t = blockIdx.x; t < ntile; t += gridDim.x) {
        const int tc = t % (DM / 64), tr = t / (DM / 64);
        {
            const int c = tid >> 3, ch = tid & 7;
            const u32x4 w = *(const u32x4*)(src + (size_t)(tc * 64 + c) * RL + tr * 64 + ch * 8);
            *(LAS u32x4*)(tile + c * 72 + ch * 8) = w;
        }
        __syncthreads();
        {
            const int tk = tid >> 3, ch = tid & 7;
            bf16_t e[8];
#pragma unroll
            for (int q = 0; q < 8; ++q) e[q] = tile[(ch * 8 + q) * 72 + tk];
            u32x4 w; w.x = e[0] | ((unsigned)e[1] << 16); w.y = e[2] | ((unsigned)e[3] << 16); w.z = e[4] | ((unsigned)e[5] << 16); w.w = e[6] | ((unsigned)e[7] << 16);
            *(u32x4*)(dst + (size_t)(tr * 64 + tk) * DM + tc * 64 + ch * 8) = w;
        }
        __syncthreads();
    }
}

template <int OFF> __device__ __forceinline__ s16x4 tr_read(unsigned addr) {
    s16x4 r; asm volatile("ds_read_b64_tr_b16 %0, %1 offset:%2" : "=&v"(r) : "v"(addr), "i"(OFF) : "memory"); return r;
}
#define MFMA32(a, b, c) __builtin_amdgcn_mfma_f32_32x32x16_bf16((a), (b), (c), 0, 0, 0)
#define PK8(L, H) ((bf16x8){L[0], L[1], L[2], L[3], H[0], H[1], H[2], H[3]})

constexpr int VSTR = 320;
template <int DQK> struct AttnGeo {
    static constexpr int KSTR = DQK * 2 + 16;
    static constexpr int KBUF = 64 * KSTR, VBUF = 64 * VSTR;
    static constexpr int VOFF = 2 * KBUF, TOTAL = 2 * KBUF + 2 * VBUF;
    static constexpr int KCH = DQK / 8;
    static constexpr int NKL = (64 * KCH) / NTHREADS;
};

template <int C> __device__ __forceinline__ void pv_block(f32x16& oc, unsigned vaddr, const bf16x8 (&pf)[4]) {
    const s16x4 l0 = tr_read<(0 * 16 + 0) * VSTR + C * 64>(vaddr), h0 = tr_read<(0 * 16 + 8) * VSTR + C * 64>(vaddr);
    const s16x4 l1 = tr_read<(1 * 16 + 0) * VSTR + C * 64>(vaddr), h1 = tr_read<(1 * 16 + 8) * VSTR + C * 64>(vaddr);
    const s16x4 l2 = tr_read<(2 * 16 + 0) * VSTR + C * 64>(vaddr), h2 = tr_read<(2 * 16 + 8) * VSTR + C * 64>(vaddr);
    const s16x4 l3 = tr_read<(3 * 16 + 0) * VSTR + C * 64>(vaddr), h3 = tr_read<(3 * 16 + 8) * VSTR + C * 64>(vaddr);
    asm volatile("s_waitcnt lgkmcnt(0)" ::: "memory"); __builtin_amdgcn_sched_barrier(0);
    oc = MFMA32(PK8(l0, h0), pf[0], oc);
    oc = MFMA32(PK8(l1, h1), pf[1], oc);
    oc = MFMA32(PK8(l2, h2), pf[2], oc);
    oc = MFMA32(PK8(l3, h3), pf[3], oc);
}

template <int DQK>
__device__ __forceinline__ void attn_unit(LAS unsigned char* lds, const bf16_t* __restrict__ qp, int qpitch,
                                          const bf16_t* __restrict__ kb, int kpitch, const bf16_t* __restrict__ krb, const bf16_t* __restrict__ vb, int vpitch,
                                          int row0, int nt0, int row1, int nt1, bool masked, int kpos0, int qpos0,
                                          float sc_l2, bool has_sink, float sink_l2, bf16_t* __restrict__ op, int opitch) {
    typedef AttnGeo<DQK> G;
    const int tid = threadIdx.x, wave = tid >> 6, lane = tid & 63, r32 = lane & 31, hi = lane >> 5;
    const int NT = nt0 + nt1;
    bf16x8 qf[DQK / 16];
    {
        const bf16_t* qrow = qp + (size_t)(wave * 32 + r32) * qpitch + hi * 8;
#pragma unroll
        for (int j = 0; j < DQK / 16; ++j) qf[j] = *(const bf16x8*)(qrow + j * 16);
    }
    u32x4 kreg[G::NKL], vreg[2];
    auto tile_row = [&](int t) -> int { return t < nt0 ? row0 + 64 * t : row1 + 64 * (t - nt0); };
#define ATT_LOAD(t) do { const int rb_ = tile_row(t); \
        _Pragma("unroll") for (int i_ = 0; i_ < G::NKL; ++i_) { const int id_ = tid + i_ * NTHREADS, rr_ = id_ / G::KCH, cc_ = id_ % G::KCH; \
            kreg[i_] = (cc_ < 16) ? *(const u32x4*)(kb + (size_t)(rb_ + rr_) * kpitch + cc_ * 8) : *(const u32x4*)(krb + (size_t)(rb_ + rr_) * 64 + (cc_ - 16) * 8); } \
        _Pragma("unroll") for (int i_ = 0; i_ < 2; ++i_) { const int id_ = tid + i_ * NTHREADS, rr_ = id_ >> 4, cc_ = id_ & 15; \
            vreg[i_] = *(const u32x4*)(vb + (size_t)(rb_ + rr_) * vpitch + cc_ * 8); } } while (0)
#define ATT_WRITE(buf) do { \
        _Pragma("unroll") for (int i_ = 0; i_ < G::NKL; ++i_) { const int id_ = tid + i_ * NTHREADS, rr_ = id_ / G::KCH, cc_ = id_ % G::KCH; \
            *(LAS u32x4*)(lds + (buf) * G::KBUF + rr_ * G::KSTR + cc_ * 16) = kreg[i_]; } \
        _Pragma("unroll") for (int i_ = 0; i_ < 2; ++i_) { const int id_ = tid + i_ * NTHREADS, rr_ = id_ >> 4, cc_ = id_ & 15; \
            *(LAS u32x4*)(lds + G::VOFF + (buf) * G::VBUF + rr_ * VSTR + cc_ * 16) = vreg[i_]; } } while (0)

    float m = has_sink ? sink_l2 : -1e30f;
    float l = (has_sink && hi == 0) ? 1.f : 0.f;
    f32x16 o[4];
#pragma unroll
    for (int c = 0; c < 4; ++c)
#pragma unroll
        for (int r = 0; r < 16; ++r) o[c][r] = 0.f;
    const int qpos = qpos0 + wave * 32 + r32;
    const unsigned vlane = (unsigned)(size_t)(lds + G::VOFF) + (unsigned)((4 * hi + ((lane & 15) >> 2)) * VSTR + ((lane >> 4) & 1) * 32 + (lane & 3) * 8);

    __syncthreads();
    ATT_LOAD(0); ATT_WRITE(0);
    __syncthreads();
    for (int t = 0; t < NT; ++t) {
        const int buf = t & 1;
        if (t + 1 < NT) ATT_LOAD(t + 1);
        f32x16 s0, s1;
#pragma unroll
        for (int r = 0; r < 16; ++r) { s0[r] = 0.f; s1[r] = 0.f; }
        {
            const LAS unsigned char* kbuf = lds + buf * G::KBUF + r32 * G::KSTR + hi * 16;
#pragma unroll
            for (int j = 0; j < DQK / 16; ++j) {
                const bf16x8 a0 = *(const LAS bf16x8*)(kbuf + j * 32);
                const bf16x8 a1 = *(const LAS bf16x8*)(kbuf + 32 * G::KSTR + j * 32);
                s0 = MFMA32(a0, qf[j], s0);
                s1 = MFMA32(a1, qf[j], s1);
            }
        }
        const bool mt = masked && (t < nt0);
        const int kp0 = kpos0 + 64 * t - qpos;
        float mx = -1e30f;
#pragma unroll
        for (int r = 0; r < 16; ++r) {
            float x0 = s0[r] * sc_l2, x1 = s1[r] * sc_l2;
            if (mt) { const int d0 = kp0 + crow(r, hi), d1 = d0 + 32; if (d0 > 128 || d0 < -128) x0 = -1e30f; if (d1 > 128 || d1 < -128) x1 = -1e30f; }
            s0[r] = x0; s1[r] = x1; mx = fmaxf(mx, fmaxf(x0, x1));
        }
        mx = fmaxf(mx, __shfl_xor(mx, 32));
        const float mn = fmaxf(m, mx);
        const float alpha = __builtin_amdgcn_exp2f(m - mn);
        m = mn;
        float ps = 0.f;
#pragma unroll
        for (int r = 0; r < 16; ++r) { const float p0 = __builtin_amdgcn_exp2f(s0[r] - mn), p1 = __builtin_amdgcn_exp2f(s1[r] - mn); s0[r] = p0; s1[r] = p1; ps += p0 + p1; }
        l = l * alpha + ps;
#pragma unroll
        for (int c = 0; c < 4; ++c)
#pragma unroll
            for (int r = 0; r < 16; ++r) o[c][r] *= alpha;
        bf16x8 pf[4];
        {
            u32x4 w;
            w.x = cvt_pk_bf16(s0[0], s0[1]); w.y = cvt_pk_bf16(s0[2], s0[3]); w.z = cvt_pk_bf16(s0[4], s0[5]); w.w = cvt_pk_bf16(s0[6], s0[7]); pf[0] = *(bf16x8*)&w;
            w.x = cvt_pk_bf16(s0[8], s0[9]); w.y = cvt_pk_bf16(s0[10], s0[11]); w.z = cvt_pk_bf16(s0[12], s0[13]); w.w = cvt_pk_bf16(s0[14], s0[15]); pf[1] = *(bf16x8*)&w;
            w.x = cvt_pk_bf16(s1[0], s1[1]); w.y = cvt_pk_bf16(s1[2], s1[3]); w.z = cvt_pk_bf16(s1[4], s1[5]); w.w = cvt_pk_bf16(s1[6], s1[7]); pf[2] = *(bf16x8*)&w;
            w.x = cvt_pk_bf16(s1[8], s1[9]); w.y = cvt_pk_bf16(s1[10], s1[11]); w.z = cvt_pk_bf16(s1[12], s1[13]); w.w = cvt_pk_bf16(s1[14], s1[15]); pf[3] = *(bf16x8*)&w;
        }
        {
            const unsigned va = vlane + (unsigned)(buf * G::VBUF);
            pv_block<0>(o[0], va, pf); pv_block<1>(o[1], va, pf); pv_block<2>(o[2], va, pf); pv_block<3>(o[3], va, pf);
        }
        if (t + 1 < NT) ATT_WRITE(buf ^ 1);
        __syncthreads();
    }
    l += __shfl_xor(l, 32);
    const float inv = 1.f / l;
    bf16_t* orow = op + (size_t)(wave * 32 + r32) * opitch + 4 * hi;
#pragma unroll
    for (int c = 0; c < 4; ++c)
#pragma unroll
        for (int g = 0; g < 4; ++g) {
            u32x2 w; w.x = cvt_pk_bf16(o[c][4 * g] * inv, o[c][4 * g + 1] * inv); w.y = cvt_pk_bf16(o[c][4 * g + 2] * inv, o[c][4 * g + 3] * inv);
            *(u32x2*)(orow + c * 32 + g * 8) = w;
        }
#undef ATT_LOAD
#undef ATT_WRITE
}

constexpr int ML_KWSTR = 320;
constexpr int ML_VSTR  = 576;
constexpr int ML_CSTR  = 272;

__device__ __forceinline__ int ml_rowbase(int b, int c) { return c == 0 ? RL + b * CTX : b * SEQ + (c - 1) * 256; }

__device__ __forceinline__ float ml_gates(LAS float* bt, LAS float* ip, LAS float* sbuf, const bf16_t* __restrict__ z1, const float* __restrict__ gate_b, int rbase, int h, int dir) {
    const int tid = threadIdx.x;
    const int j = dir ? 255 - tid : tid;
    if (tid < 256) {
        const bf16_t* zr = z1 + (size_t)(rbase + tid) * 6400 + 6144 + dir * 8 + h;
        const float gi = bf2f(zr[0]) + gate_b[dir * 8 + h];
        const float gf = bf2f(zr[16]) + gate_b[16 + dir * 8 + h];
        const float lf = fminf(gf, 0.f) - log1pf(__expf(-fabsf(gf)));
        ip[tid] = gi; sbuf[j] = lf;
    }
    __syncthreads();
    for (int off = 1; off < 256; off <<= 1) {
        float v = 0.f;
        if (tid < 256 && tid >= off) v = sbuf[tid - off];
        __syncthreads();
        if (tid < 256) sbuf[tid] += v;
        __syncthreads();
    }
    if (tid < 256) bt[tid] = sbuf[j];
    const float bend = sbuf[255];
    __syncthreads();
    return bend;
}

__device__ __forceinline__ void ph_ml_p1(LAS unsigned char* lds, const bf16_t* __restrict__ z1, const float* __restrict__ gate_b, float* __restrict__ DC, float* __restrict__ DN, float* __restrict__ AC) {
    const int tid = threadIdx.x, wave = tid >> 6, lane = tid & 63, r32 = lane & 31, hi = lane >> 5;
    LAS float* bt = (LAS float*)lds; LAS float* ip = bt + 256; LAS float* sbuf = ip + 256; LAS float* wv = sbuf + 256;
    LAS unsigned char* kw = lds + 4096;
    LAS unsigned char* vt = kw + 64 * ML_KWSTR;
    const unsigned lane_off = (unsigned)((4 * hi + ((lane & 15) >> 2))) ;
    const unsigned kaddr = (unsigned)(size_t)kw + lane_off * ML_KWSTR + ((lane >> 4) & 1) * 32 + (lane & 3) * 8;
    const unsigned vaddr = (unsigned)(size_t)vt + lane_off * ML_VSTR + ((lane >> 4) & 1) * 32 + (lane & 3) * 8 + wave * 64;
    for (int item = blockIdx.x; item < 1088; item += gridDim.x) {
        const int c = item % 17, seq = item / 17, dir = seq & 1, h = (seq >> 1) & 7, b = seq >> 4;
        const int rbase = ml_rowbase(b, c);
        const float bend = ml_gates(bt, ip, sbuf, z1, gate_b, rbase, h, dir);
        if (tid < 256) wv[tid] = __expf(bend - bt[tid] + ip[tid]);
        f32x16 acc[4];
#pragma unroll
        for (int dt = 0; dt < 4; ++dt)
#pragma unroll
            for (int r = 0; r < 16; ++r) acc[dt][r] = 0.f;
        float dn = 0.f;
        for (int st = 0; st < 4; ++st) {
            __syncthreads();
#pragma unroll
            for (int i = 0; i < 2; ++i) {
                const int id = tid + i * NTHREADS, rr = id >> 4, cc = id & 15;
                const u32x4 kx = *(const u32x4*)(z1 + (size_t)(rbase + st * 64 + rr) * 6400 + 1024 + h * 128 + cc * 8);
                const float w = wv[st * 64 + rr];
                u32x4 o; o.x = cvt_pk_bf16(bflo(kx.x) * w, bfhi(kx.x) * w); o.y = cvt_pk_bf16(bflo(kx.y) * w, bfhi(kx.y) * w);
                o.z = cvt_pk_bf16(bflo(kx.z) * w, bfhi(kx.z) * w); o.w = cvt_pk_bf16(bflo(kx.w) * w, bfhi(kx.w) * w);
                *(LAS u32x4*)(kw + rr * ML_KWSTR + cc * 16) = o;
            }
#pragma unroll
            for (int i = 0; i < 4; ++i) {
                const int id = tid + i * NTHREADS, rr = id >> 5, cc = id & 31;
                const u32x4 vx = *(const u32x4*)(z1 + (size_t)(rbase + st * 64 + rr) * 6400 + 2048 + h * 256 + cc * 8);
                *(LAS u32x4*)(vt + rr * ML_VSTR + cc * 16) = vx;
            }
            __syncthreads();
            if (tid < 128) {
#pragma unroll 8
                for (int s = 0; s < 64; ++s) dn += bf2f(*(const LAS bf16_t*)(kw + s * ML_KWSTR + tid * 2));
            }
#define ML_P1_STEP(KS) do { \
                const s16x4 al = tr_read<(KS * 16 + 0) * ML_VSTR>(vaddr), ah = tr_read<(KS * 16 + 8) * ML_VSTR>(vaddr); \
                const s16x4 b0l = tr_read<(KS * 16 + 0) * ML_KWSTR + 0>(kaddr), b0h = tr_read<(KS * 16 + 8) * ML_KWSTR + 0>(kaddr); \
                const s16x4 b1l = tr_read<(KS * 16 + 0) * ML_KWSTR + 64>(kaddr), b1h = tr_read<(KS * 16 + 8) * ML_KWSTR + 64>(kaddr); \
                const s16x4 b2l = tr_read<(KS * 16 + 0) * ML_KWSTR + 128>(kaddr), b2h = tr_read<(KS * 16 + 8) * ML_KWSTR + 128>(kaddr); \
                const s16x4 b3l = tr_read<(KS * 16 + 0) * ML_KWSTR + 192>(kaddr), b3h = tr_read<(KS * 16 + 8) * ML_KWSTR + 192>(kaddr); \
                asm volatile("s_waitcnt lgkmcnt(0)" ::: "memory"); __builtin_amdgcn_sched_barrier(0); \
                const bf16x8 af = PK8(al, ah); \
                acc[0] = MFMA32(af, PK8(b0l, b0h), acc[0]); acc[1] = MFMA32(af, PK8(b1l, b1h), acc[1]); \
                acc[2] = MFMA32(af, PK8(b2l, b2h), acc[2]); acc[3] = MFMA32(af, PK8(b3l, b3h), acc[3]); } while (0)
            ML_P1_STEP(0); ML_P1_STEP(1); ML_P1_STEP(2); ML_P1_STEP(3);
#undef ML_P1_STEP
        }
        float* dc = DC + (size_t)item * 32768;
#pragma unroll
        for (int dt = 0; dt < 4; ++dt)
#pragma unroll
            for (int r = 0; r < 16; ++r) dc[(size_t)(32 * wave + crow(r, hi)) * 128 + dt * 32 + r32] = acc[dt][r];
        if (tid < 128) DN[(size_t)item * 128 + tid] = dn;
        if (tid == 0) AC[item] = __expf(bend);
        __syncthreads();
    }
}

__device__ __forceinline__ void ph_ml_p2(const float* __restrict__ DC, const float* __restrict__ DN, const float* __restrict__ AC, bf16_t* __restrict__ CS, float* __restrict__ NS) {
    const int gt = blockIdx.x * NTHREADS + threadIdx.x, gn = gridDim.x * NTHREADS;
    for (int i = gt; i < 64 * 8192; i += gn) {
        const int seq = i >> 13, e4 = i & 8191, dir = seq & 1;
        f32x4 C = {0.f, 0.f, 0.f, 0.f};
        for (int j = 0; j < 17; ++j) {
            const int c = dir ? (j == 0 ? 0 : 17 - j) : j;
            const size_t item = (size_t)seq * 17 + c;
            u32x2 w; w.x = cvt_pk_bf16(C[0], C[1]); w.y = cvt_pk_bf16(C[2], C[3]);
            *(u32x2*)(CS + item * 32768 + e4 * 4) = w;
            if (j < 16) { const float a = AC[item]; const f32x4 d = *(const f32x4*)(DC + item * 32768 + e4 * 4); C = C * a + d; }
        }
    }
    for (int i = gt; i < 64 * 128; i += gn) {
        const int seq = i >> 7, e = i & 127, dir = seq & 1;
        float n = 0.f;
        for (int j = 0; j < 17; ++j) {
            const int c = dir ? (j == 0 ? 0 : 17 - j) : j;
            const size_t item = (size_t)seq * 17 + c;
            NS[item * 128 + e] = n;
            if (j < 16) n = n * AC[item] + DN[item * 128 + e];
        }
    }
}

__device__ __forceinline__ void ph_ml_p3(LAS unsigned char* lds, const bf16_t* __restrict__ z1, const float* __restrict__ gate_b, const bf16_t* __restrict__ CS, const float* __restrict__ NS, bf16_t* __restrict__ HD) {
    const int tid = threadIdx.x, wave = tid >> 6, lane = tid & 63, r32 = lane & 31, hi = lane >> 5;
    LAS float* bt = (LAS float*)lds; LAS float* ip = bt + 256; LAS float* sbuf = ip + 256; LAS float* ck = sbuf + 256; LAS float* nst = ck + 256;
    LAS unsigned char* cst = lds + 5120;
    LAS unsigned char* kt = cst + 128 * ML_CSTR;
    LAS unsigned char* vt = kt + 64 * ML_CSTR;
    const unsigned vlane = (unsigned)(size_t)vt + (unsigned)((4 * hi + ((lane & 15) >> 2)) * VSTR + ((lane >> 4) & 1) * 32 + (lane & 3) * 8);
    for (int it = blockIdx.x; it < 2176; it += gridDim.x) {
        const int vh = it & 1, item = it >> 1;
        const int c = item % 17, seq = item / 17, dir = seq & 1, h = (seq >> 1) & 7, b = seq >> 4;
        const int rbase = ml_rowbase(b, c);
        (void)ml_gates(bt, ip, sbuf, z1, gate_b, rbase, h, dir);
        if (tid < 256) ck[tid] = ip[tid] - bt[tid];
        if (tid < 128) nst[tid] = NS[(size_t)item * 128 + tid];
#pragma unroll
        for (int i = 0; i < 4; ++i) {
            const int id = tid + i * NTHREADS, rr = id >> 4, cc = id & 15;
            const u32x4 x = *(const u32x4*)(CS + (size_t)item * 32768 + (size_t)(vh * 128 + rr) * 128 + cc * 8);
            *(LAS u32x4*)(cst + rr * ML_CSTR + cc * 16) = x;
        }
        const int tq = wave * 32 + r32;
        bf16x8 qf[8];
        {
            const bf16_t* qrow = z1 + (size_t)(rbase + tq) * 6400 + h * 128 + hi * 8;
#pragma unroll
            for (int j = 0; j < 8; ++j) qf[j] = *(const bf16x8*)(qrow + j * 16);
        }
        __syncthreads();
        const float bq = bt[tq];
        const float g = __expf(bq);
        f32x16 o[4];
#pragma unroll
        for (int c4 = 0; c4 < 4; ++c4)
#pragma unroll
            for (int r = 0; r < 16; ++r) o[c4][r] = 0.f;
        float den = 0.f;
        {
            const LAS unsigned char* cb = cst + r32 * ML_CSTR + hi * 16;
#pragma unroll
            for (int j = 0; j < 8; ++j) {
#pragma unroll
                for (int c4 = 0; c4 < 4; ++c4) { const bf16x8 a = *(const LAS bf16x8*)(cb + c4 * 32 * ML_CSTR + j * 32); o[c4] = MFMA32(a, qf[j], o[c4]); }
                const f32x4 n0 = *(const LAS f32x4*)(nst + 16 * j + 8 * hi), n1 = *(const LAS f32x4*)(nst + 16 * j + 8 * hi + 4);
                const u32x4 qw = *(const u32x4*)&qf[j];
                den += bflo(qw.x) * n0[0] + bfhi(qw.x) * n0[1] + bflo(qw.y) * n0[2] + bfhi(qw.y) * n0[3] + bflo(qw.z) * n1[0] + bfhi(qw.z) * n1[1] + bflo(qw.w) * n1[2] + bfhi(qw.w) * n1[3];
            }
#pragma unroll
            for (int c4 = 0; c4 < 4; ++c4)
#pragma unroll
                for (int r = 0; r < 16; ++r) o[c4][r] *= g;
            den *= g;
        }
        for (int kti = 0; kti < 4; ++kti) {
            __syncthreads();
#pragma unroll
            for (int i = 0; i < 2; ++i) {
                const int id = tid + i * NTHREADS, rr = id >> 4, cc = id & 15;
                const size_t ro = (size_t)(rbase + kti * 64 + rr) * 6400;
                *(LAS u32x4*)(kt + rr * ML_CSTR + cc * 16) = *(const u32x4*)(z1 + ro + 1024 + h * 128 + cc * 8);
                *(LAS u32x4*)(vt + rr * VSTR + cc * 16) = *(const u32x4*)(z1 + ro + 2048 + h * 256 + vh * 128 + cc * 8);
            }
            __syncthreads();
            const bool rel = dir ? (64 * kti + 63 >= 32 * wave) : (64 * kti <= 32 * wave + 31);
            if (rel) {
                f32x16 s0, s1;
#pragma unroll
                for (int r = 0; r < 16; ++r) { s0[r] = 0.f; s1[r] = 0.f; }
                const LAS unsigned char* kb = kt + r32 * ML_CSTR + hi * 16;
#pragma unroll
                for (int j = 0; j < 8; ++j) {
                    const bf16x8 a0 = *(const LAS bf16x8*)(kb + j * 32), a1 = *(const LAS bf16x8*)(kb + 32 * ML_CSTR + j * 32);
                    s0 = MFMA32(a0, qf[j], s0); s1 = MFMA32(a1, qf[j], s1);
                }
                float ps = 0.f;
#pragma unroll
                for (int gq = 0; gq < 4; ++gq) {
                    const int k0 = 64 * kti + 8 * gq + 4 * hi;
                    const f32x4 c0 = *(const LAS f32x4*)(ck + k0), c1 = *(const LAS f32x4*)(ck + k0 + 32);
#pragma unroll
                    for (int e = 0; e < 4; ++e) {
                        const int ts0 = k0 + e, ts1 = ts0 + 32;
                        const bool v0 = dir ? (ts0 >= tq) : (ts0 <= tq), v1 = dir ? (ts1 >= tq) : (ts1 <= tq);
                        const float w0 = v0 ? __expf(bq + c0[e]) : 0.f, w1 = v1 ? __expf(bq + c1[e]) : 0.f;
                        const float p0 = s0[4 * gq + e] * w0, p1 = s1[4 * gq + e] * w1;
                        s0[4 * gq + e] = p0; s1[4 * gq + e] = p1; ps += p0 + p1;
                    }
                }
                den += ps;
                bf16x8 pf[4];
                {
                    u32x4 w;
                    w.x = cvt_pk_bf16(s0[0], s0[1]); w.y = cvt_pk_bf16(s0[2], s0[3]); w.z = cvt_pk_bf16(s0[4], s0[5]); w.w = cvt_pk_bf16(s0[6], s0[7]); pf[0] = *(bf16x8*)&w;
                    w.x = cvt_pk_bf16(s0[8], s0[9]); w.y = cvt_pk_bf16(s0[10], s0[11]); w.z = cvt_pk_bf16(s0[12], s0[13]); w.w = cvt_pk_bf16(s0[14], s0[15]); pf[1] = *(bf16x8*)&w;
                    w.x = cvt_pk_bf16(s1[0], s1[1]); w.y = cvt_pk_bf16(s1[2], s1[3]); w.z = cvt_pk_bf16(s1[4], s1[5]); w.w = cvt_pk_bf16(s1[6], s1[7]); pf[2] = *(bf16x8*)&w;
                    w.x = cvt_pk_bf16(s1[8], s1[9]); w.y = cvt_pk_bf16(s1[10], s1[11]); w.z = cvt_pk_bf16(s1[12], s1[13]); w.w = cvt_pk_bf16(s1[14], s1[15]); pf[3] = *(bf16x8*)&w;
                }
                pv_block<0>(o[0], vlane, pf); pv_block<1>(o[1], vlane, pf); pv_block<2>(o[2], vlane, pf); pv_block<3>(o[3], vlane, pf);
            }
        }
        den += __shfl_xor(den, 32);
        const float inv = 1.f / fmaxf(fabsf(den), 1.f);
        bf16_t* orow = HD + (size_t)dir * RA * DM + (size_t)(rbase + tq) * DM + h * 256 + vh * 128 + 4 * hi;
#pragma unroll
        for (int c4 = 0; c4 < 4; ++c4)
#pragma unroll
            for (int gq = 0; gq < 4; ++gq) {
                u32x2 w; w.x = cvt_pk_bf16(o[c4][4 * gq] * inv, o[c4][4 * gq + 1] * inv); w.y = cvt_pk_bf16(o[c4][4 * gq + 2] * inv, o[c4][4 * gq + 3] * inv);
                *(u32x2*)(orow + c4 * 32 + gq * 8) = w;
            }
        __syncthreads();
    }
}

__device__ __forceinline__ f32x2 cmul(f32x2 a, f32x2 b) { f32x2 r; r.x = a.x * b.x - a.y * b.y; r.y = a.x * b.y + a.y * b.x; return r; }
__device__ __forceinline__ void fft_fwd(LAS f32x2* buf, const f32x2* __restrict__ tw) {
    const int tid = threadIdx.x;
#pragma unroll 1
    for (int lh = 12; lh >= 0; --lh) {
        const int half = 1 << lh;
#pragma unroll
        for (int q = 0; q < 8; ++q) {
            const int j = tid + q * NTHREADS, pos = j & (half - 1), i0 = ((j >> lh) << (lh + 1)) + pos, i1 = i0 + half;
            const f32x2 w = tw[pos << (12 - lh)];
            const f32x2 a = buf[i0], b = buf[i1];
            f32x2 s, d; s.x = a.x + b.x; s.y = a.y + b.y; d.x = a.x - b.x; d.y = a.y - b.y;
            buf[i0] = s; buf[i1] = cmul(d, w);
        }
        __syncthreads();
    }
}
__device__ __forceinline__ void fft_inv(LAS f32x2* buf, const f32x2* __restrict__ tw) {
    const int tid = threadIdx.x;
#pragma unroll 1
    for (int lh = 0; lh <= 12; ++lh) {
        const int half = 1 << lh;
#pragma unroll
        for (int q = 0; q < 8; ++q) {
            const int j = tid + q * NTHREADS, pos = j & (half - 1), i0 = ((j >> lh) << (lh + 1)) + pos, i1 = i0 + half;
            f32x2 w = tw[pos << (12 - lh)]; w.y = -w.y;
            const f32x2 a = buf[i0], b = cmul(buf[i1], w);
            f32x2 s, d; s.x = a.x + b.x; s.y = a.y + b.y; d.x = a.x - b.x; d.y = a.y - b.y;
            buf[i0] = s; buf[i1] = d;
        }
        __syncthreads();
    }
}
__device__ __forceinline__ float hy_sc(const bf16_t* __restrict__ zrow, int t, float w0, float w1, float w2, float cb) {
    const float zm = t > 0 ? bf2f(zrow[t - 1]) : 0.f, z0 = bf2f(zrow[t]), zp = t < SEQ - 1 ? bf2f(zrow[t + 1]) : 0.f;
    return zm * w0 + z0 * w1 + zp * w2 + cb;
}

__device__ __forceinline__ void ph_hyena(LAS unsigned char* lds, const bf16_t* __restrict__ ZT, const float* __restrict__ conv_w, const float* __restrict__ conv_b,
                                         const float* __restrict__ a3T, const float* __restrict__ w4, const float* __restrict__ b4, const float* __restrict__ decay, const float* __restrict__ skip,
                                         const f32x2* __restrict__ tw, float* __restrict__ y1s, bf16_t* __restrict__ Y2T) {
    LAS f32x2* H = (LAS f32x2*)lds;
    LAS f32x2* X = (LAS f32x2*)(lds + 65536);
    const int tid = threadIdx.x;
    float* y1 = y1s + (size_t)blockIdx.x * 4 * SEQ;
    for (int ch = blockIdx.x; ch < DM; ch += gridDim.x) {
        const int cx1 = ch, cx2 = DM + ch, cv = 2 * DM + ch;
        const float x1w0 = conv_w[cx1], x1w1 = conv_w[3 * DM + cx1], x1w2 = conv_w[6 * DM + cx1], x1b = conv_b[cx1];
        const float x2w0 = conv_w[cx2], x2w1 = conv_w[3 * DM + cx2], x2w2 = conv_w[6 * DM + cx2], x2b = conv_b[cx2];
        const float vw0 = conv_w[cv], vw1 = conv_w[3 * DM + cv], vw2 = conv_w[6 * DM + cv], vb = conv_b[cv];
#pragma unroll 1
        for (int ord = 0; ord < 2; ++ord) {
            const int colf = ord * DM + ch, colb = 2 * DM + ord * DM + ch;
            const float bf_ = b4[colf], bb_ = b4[colb], df = fabsf(decay[colf]), db = fabsf(decay[colb]);
            __syncthreads();
#pragma unroll 1
            for (int q = 0; q < 8; ++q) {
                const int l = tid + q * NTHREADS;
                float af = bf_, ab = bb_;
#pragma unroll 8
                for (int k = 0; k < 64; ++k) { const float a = a3T[k * 4096 + l]; af += a * w4[k * 8192 + colf]; ab += a * w4[k * 8192 + colb]; }
                const float tl = (float)l * (1.0f / 4095.0f);
                af *= __expf(-tl * df); ab *= __expf(-tl * db);
                f32x2 v; v.x = af; v.y = 0.f; H[l] = v;
                if (l >= 1) { v.x = ab; H[8192 - l] = v; }
                if (l == 0) { v.x = 0.f; H[4096] = v; }
            }
            __syncthreads();
            fft_fwd(H, tw);
            const float sk = skip[ord * DM + ch];
#pragma unroll 1
            for (int pr = 0; pr < 2; ++pr) {
                const int b0 = 2 * pr, b1 = 2 * pr + 1;
                const bf16_t* zv0 = ZT + (size_t)cv * RL + b0 * SEQ; const bf16_t* zv1 = ZT + (size_t)cv * RL + b1 * SEQ;
#pragma unroll 1
                for (int q = 0; q < 8; ++q) {
                    const int t = tid + q * NTHREADS;
                    f32x2 v;
                    if (ord == 0) { v.x = hy_sc(zv0, t, vw0, vw1, vw2, vb); v.y = hy_sc(zv1, t, vw0, vw1, vw2, vb); }
                    else { v.x = y1[b0 * SEQ + t]; v.y = y1[b1 * SEQ + t]; }
                    X[t] = v;
                    f32x2 z; z.x = 0.f; z.y = 0.f; X[4096 + t] = z;
                }
                __syncthreads();
                fft_fwd(X, tw);
#pragma unroll
                for (int q = 0; q < 16; ++q) { const int i = tid + q * NTHREADS; X[i] = cmul(X[i], H[i]); }
                __syncthreads();
                fft_inv(X, tw);
                const bf16_t* zg0 = ZT + (size_t)(ord == 0 ? cx1 : cx2) * RL + b0 * SEQ; const bf16_t* zg1 = ZT + (size_t)(ord == 0 ? cx1 : cx2) * RL + b1 * SEQ;
                const float gw0 = ord == 0 ? x1w0 : x2w0, gw1 = ord == 0 ? x1w1 : x2w1, gw2 = ord == 0 ? x1w2 : x2w2, gb = ord == 0 ? x1b : x2b;
#pragma unroll 1
                for (int q = 0; q < 8; ++q) {
                    const int t = tid + q * NTHREADS;
                    const f32x2 cvv = X[t];
                    float in0, in1;
                    if (ord == 0) { in0 = hy_sc(zv0, t, vw0, vw1, vw2, vb); in1 = hy_sc(zv1, t, vw0, vw1, vw2, vb); }
                    else { in0 = y1[b0 * SEQ + t]; in1 = y1[b1 * SEQ + t]; }
                    const float r0 = hy_sc(zg0, t, gw0, gw1, gw2, gb) * (cvv.x * (1.0f / 8192.0f) + in0 * sk);
                    const float r1 = hy_sc(zg1, t, gw0, gw1, gw2, gb) * (cvv.y * (1.0f / 8192.0f) + in1 * sk);
                    if (ord == 0) { y1[b0 * SEQ + t] = r0; y1[b1 * SEQ + t] = r1; }
                    else { Y2T[(size_t)ch * RL + b0 * SEQ + t] = f2bf(r0); Y2T[(size_t)ch * RL + b1 * SEQ + t] = f2bf(r1); }
                }
                __syncthreads();
            }
        }
    }
}

constexpr int N_IN = 37;
enum { I_X = 0, I_C, I_CTX, I_CCTX, I_ADAW, I_ADAB, I_NORMG, I_W1, I_W2, I_SWQKV, I_SWSINK, I_SWWO, I_MLWIN, I_MLGB, I_MLHG, I_MLWO,
       I_MAWIN, I_MAQG, I_MAKVG, I_MAUQ, I_MAUKV, I_MAWO, I_HYWIN, I_HYCW, I_HYCB, I_HYW1, I_HYB1, I_HYW2, I_HYB2, I_HYW3, I_HYB3, I_HYW4, I_HYB4, I_HYFREQ, I_HYDECAY, I_HYSKIP, I_HYWO };
struct Args { const float* in[N_IN]; float* out; unsigned char* ws; int ph_lo, ph_hi; };
constexpr int N_PHASES = 36;

__global__ void __launch_bounds__(NTHREADS, 2) mk_fwd(Args args) {
    extern __shared__ __attribute__((aligned(16))) unsigned char lds_raw[];
    LAS unsigned char* lds = (LAS unsigned char*)lds_raw;
    unsigned char* ws = args.ws;
    const int tid = threadIdx.x;
    volatile LAS unsigned* misc = (volatile LAS unsigned*)(lds + LDS_MISC);
    if (tid < 4) misc[tid] = 0u;
    __syncthreads();
#if MK_ONE_LAUNCH
    XcdBarrier bar = xcd_barrier_post((unsigned*)(ws + WS_CTL), misc);
#define GRID_BAR() xcd_barrier(bar)
#else
#define GRID_BAR() do {} while (0)
#endif
    const int lo = args.ph_lo, hi = args.ph_hi;
#define IN(k) (lo <= (k) && (k) < hi)
#define SEAM(k) do { if (IN(k) && IN((k) + 1)) GRID_BAR(); } while (0)

    const float* x = args.in[I_X]; const float* cin = args.in[I_CTX];
    float* mods = (float*)(ws + WS_MODS);
    const f32x2* ropeA = (const f32x2*)(ws + WS_ROPEA); const f32x2* ropeC = (const f32x2*)(ws + WS_ROPEC); const f32x2* tw = (const f32x2*)(ws + WS_TW);
    float* a3T = (float*)(ws + WS_A3T);
    bf16_t* W1T = (bf16_t*)(ws + WS_W1T); bf16_t* W2T = (bf16_t*)(ws + WS_W2T);
    float* H = (float*)(ws + WS_H); bf16_t* U = (bf16_t*)(ws + WS_U); float* Y = (float*)(ws + WS_Y); bf16_t* O = (bf16_t*)(ws + WS_O); bf16_t* T = (bf16_t*)(ws + WS_T);
    const float* normg = args.in[I_NORMG];
    constexpr float LOG2E = 1.4426950408889634f;

    if (IN(0)) {
        ph_mods(lds, args.in[I_C], args.in[I_CCTX], args.in[I_ADAW], args.in[I_ADAB], mods);
        ph_tables((f32x2*)(ws + WS_ROPEA), (f32x2*)(ws + WS_ROPEC), (f32x2*)(ws + WS_TW));
        ph_hyena_feats(lds, args.in[I_HYW1], args.in[I_HYB1], args.in[I_HYW2], args.in[I_HYB2], args.in[I_HYW3], args.in[I_HYB3], args.in[I_HYFREQ], a3T);
        __syncthreads();
#pragma unroll 1
        for (int l = 0; l < 4; ++l) {
            conv_weight(lds, args.in[I_W1] + (size_t)l * DM * FF, W1T + (size_t)l * FF * DM, DM, FF, FF, 0, 0, 1.f);
            conv_weight(lds, args.in[I_W2] + (size_t)l * FF * DM, W2T + (size_t)l * DM * FF, FF, DM, DM, 0, 0, 1.f);
        }
        conv_weight(lds, args.in[I_SWQKV], (bf16_t*)(ws + WS_QKVT), DM, 3072, 3072, 1, 0, 1.f);
        conv_weight(lds, args.in[I_SWWO], (bf16_t*)(ws + WS_SWOT), DM, DM, DM, 0, 0, 1.f);
        conv_weight(lds, args.in[I_MLWIN], (bf16_t*)(ws + WS_MLIN), DM, 6176, 6400, 0, 1024, 0.08838834764831845f);
        conv_weight(lds, args.in[I_MLWO], (bf16_t*)(ws + WS_MLO), DM, DM, DM, 0, 0, 1.f);
        conv_weight(lds, args.in[I_MAWIN], (bf16_t*)(ws + WS_MAIN), DM, 1088, 1280, 2, 0, 1.f);
        conv_weight(lds, args.in[I_MAUQ], (bf16_t*)(ws + WS_MUQ), 512, 3072, 3072, 3, 0, 1.f);
        conv_weight(lds, args.in[I_MAUKV], (bf16_t*)(ws + WS_MUKV), 512, 4096, 4096, 0, 0, 1.f);
        conv_weight(lds, args.in[I_MAWO], (bf16_t*)(ws + WS_MAO), DM, DM, DM, 0, 0, 1.f);
        conv_weight(lds, args.in[I_HYWIN], (bf16_t*)(ws + WS_HYIN), DM, 6144, 6144, 0, 0, 1.f);
        conv_weight(lds, args.in[I_HYWO], (bf16_t*)(ws + WS_HYO), DM, DM, DM, 0, 0, 1.f);
    }
    SEAM(0);
    if (IN(1)) ph_normmod(x, cin, H, true, normg + (0 * 4 + 0) * DM, mods + (size_t)0 * 5 * NMOD, 0, 1, U, RA);
    SEAM(1);
    if (IN(2)) {
        EpiG<0> e = mk_epi<0>(ws + WS_QKV, 3072); e.rope = ropeA; e.head_w = 128; e.rope_off = 0; e.rope_cols = 2560; e.tab_stride = 64; e.rope_rows = RL;
        run_gemm<0>(lds, U, (const bf16_t*)(ws + WS_QKVT), RA, 3072, DM, e);
    }
    SEAM(2);
    if (IN(3)) {
        const bf16_t* qkv = (const bf16_t*)(ws + WS_QKV);
        const float* sink = args.in[I_SWSINK];
        const float sc = 0.08838834764831845f * LOG2E;
#pragma unroll 1
        for (int u = blockIdx.x; u < 1024 + 64; u += gridDim.x) {
            int b, hq, qrow0, row0, nt0, kpos0, qpos0;
            if (u < 1024) {
                const int qb = u & 15; hq = (u >> 4) & 15; b = u >> 8;
                const int t0 = qb * 256, ks = t0 - 128 < 0 ? 0 : t0 - 128, ke = t0 + 384 > SEQ ? SEQ : t0 + 384;
                qrow0 = b * SEQ + t0; row0 = b * SEQ + ks; nt0 = (ke - ks) >> 6; kpos0 = ks; qpos0 = t0;
            } else { const int v = u - 1024; hq = v & 15; b = v >> 4; qrow0 = RL + b * CTX; row0 = 0; nt0 = 0; kpos0 = 0; qpos0 = 0; }
            const int kvh = hq >> 2;
            attn_unit<128>(lds, qkv + (size_t)qrow0 * 3072 + hq * 128, 3072, qkv + 2048 + kvh * 128, 3072, nullptr, qkv + 2560 + kvh * 128, 3072,
                           row0, nt0, RL + b * CTX, 4, true, kpos0, qpos0, sc, true, sink[hq] * LOG2E, O + (size_t)qrow0 * DM + hq * 128, DM);
        }
    }
    SEAM(3);
    if (IN(4)) { EpiG<2> e = mk_epi<2>(Y, DM); run_gemm<2>(lds, O, (const bf16_t*)(ws + WS_SWOT), RA, DM, DM, e); }
    SEAM(4);
    if (IN(5)) ph_resid(Y, normg + (0 * 4 + 1) * DM, mods + (size_t)0 * 5 * NMOD, 2, x, cin, H, true, H, true, normg + (0 * 4 + 2) * DM, mods + (size_t)0 * 5 * NMOD, 3, 4, U, RA);
    SEAM(5);
    if (IN(6)) { EpiG<1> e = mk_epi<1>(T, FF); run_gemm<1>(lds, U, W1T + (size_t)0 * FF * DM, RA, FF, DM, e); }
    SEAM(6);
    if (IN(7)) { EpiG<2> e = mk_epi<2>(Y, DM); run_gemm<2>(lds, T, W2T + (size_t)0 * DM * FF, RA, DM, FF, e); }
    SEAM(7);
    if (IN(8)) ph_resid(Y, normg + (0 * 4 + 3) * DM, mods + (size_t)0 * 5 * NMOD, 5, x, cin, H, false, H, true, normg + (1 * 4 + 0) * DM, mods + (size_t)1 * 5 * NMOD, 0, 1, U, RA);
    SEAM(8);
    if (IN(9)) { EpiG<0> e = mk_epi<0>(ws + WS_Z1, 6400); run_gemm<0>(lds, U, (const bf16_t*)(ws + WS_MLIN), RA, 6400, DM, e); }
    SEAM(9);
    if (IN(10)) ph_ml_p1(lds, (const bf16_t*)(ws + WS_Z1), args.in[I_MLGB], (float*)(ws + WS_DC), (float*)(ws + WS_DN), (float*)(ws + WS_AC));
    SEAM(10);
    if (IN(11)) ph_ml_p2((const float*)(ws + WS_DC), (const float*)(ws + WS_DN), (const float*)(ws + WS_AC), (bf16_t*)(ws + WS_CS), (float*)(ws + WS_NS));
    SEAM(11);
    if (IN(12)) ph_ml_p3(lds, (const bf16_t*)(ws + WS_Z1), args.in[I_MLGB], (const bf16_t*)(ws + WS_CS), (const float*)(ws + WS_NS), (bf16_t*)(ws + WS_HD));
    SEAM(12);
    if (IN(13)) ph_headnorm((const bf16_t*)(ws + WS_HD), (const bf16_t*)(ws + WS_HD) + (size_t)RA * DM, (const bf16_t*)(ws + WS_Z1), args.in[I_MLHG], O);
    SEAM(13);
    if (IN(14)) { EpiG<2> e = mk_epi<2>(Y, DM); run_gemm<2>(lds, O, (const bf16_t*)(ws + WS_MLO), RA, DM, DM, e); }
    SEAM(14);
    if (IN(15)) ph_resid(Y, normg + (1 * 4 + 1) * DM, mods + (size_t)1 * 5 * NMOD, 2, x, cin, H, false, H, true, normg + (1 * 4 + 2) * DM, mods + (size_t)1 * 5 * NMOD, 3, 4, U, RA);
    SEAM(15);
    if (IN(16)) { EpiG<1> e = mk_epi<1>(T, FF); run_gemm<1>(lds, U, W1T + (size_t)1 * FF * DM, RA, FF, DM, e); }
    SEAM(16);
    if (IN(17)) { EpiG<2> e = mk_epi<2>(Y, DM); run_gemm<2>(lds, T, W2T + (size_t)1 * DM * FF, RA, DM, FF, e); }
    SEAM(17);
    if (IN(18)) ph_resid(Y, normg + (1 * 4 + 3) * DM, mods + (size_t)1 * 5 * NMOD, 5, x, cin, H, false, H, true, normg + (2 * 4 + 0) * DM, mods + (size_t)2 * 5 * NMOD, 0, 1, U, RA);
    SEAM(18);
    if (IN(19)) { EpiG<2> e = mk_epi<2>(ws + WS_Z2, 1280); run_gemm<2>(lds, U, (const bf16_t*)(ws + WS_MAIN), RA, 1280, DM, e); }
    SEAM(19);
    if (IN(20)) ph_mla_rows((const float*)(ws + WS_Z2), args.in[I_MAQG], args.in[I_MAKVG], ropeC, (bf16_t*)(ws + WS_ZQ), (bf16_t*)(ws + WS_ZKV), (bf16_t*)(ws + WS_KR));
    SEAM(20);
    if (IN(21)) {
        { EpiG<0> e = mk_epi<0>(ws + WS_Q2, 3072); e.rope = ropeC; e.head_w = 192; e.rope_off = 128; e.rope_cols = 3072; e.tab_stride = 32; e.rope_rows = RL;
          run_gemm<0>(lds, (const bf16_t*)(ws + WS_ZQ), (const bf16_t*)(ws + WS_MUQ), RL, 3072, 512, e); }
        { EpiG<0> e = mk_epi<0>(ws + WS_KV, 4096); run_gemm<0>(lds, (const bf16_t*)(ws + WS_ZKV), (const bf16_t*)(ws + WS_MUKV), RA, 4096, 512, e); }
    }
    SEAM(21);
    if (IN(22)) {
        const bf16_t* q2 = (const bf16_t*)(ws + WS_Q2); const bf16_t* kv = (const bf16_t*)(ws + WS_KV); const bf16_t* kr = (const bf16_t*)(ws + WS_KR);
        const float sc = 0.07216878364870323f * LOG2E;
#pragma unroll 1
        for (int u = blockIdx.x; u < 1024; u += gridDim.x) {
            const int qb = u & 15, hh = (u >> 4) & 15, b = u >> 8;
            const int qrow0 = b * SEQ + qb * 256;
            attn_unit<192>(lds, q2 + (size_t)qrow0 * 3072 + hh * 192, 3072, kv + hh * 256, 4096, kr, kv + hh * 256 + 128, 4096,
                           b * SEQ, 64, RL + b * CTX, 4, false, 0, 0, sc, false, 0.f, O + (size_t)qrow0 * DM + hh * 128, DM);
        }
    }
    SEAM(22);
    if (IN(23)) { EpiG<2> e = mk_epi<2>(Y, DM); run_gemm<2>(lds, O, (const bf16_t*)(ws + WS_MAO), RL, DM, DM, e); }
    SEAM(23);
    if (IN(24)) ph_resid(Y, normg + (2 * 4 + 1) * DM, mods + (size_t)2 * 5 * NMOD, 2, x, cin, H, false, H, true, normg + (2 * 4 + 2) * DM, mods + (size_t)2 * 5 * NMOD, 3, 4, U, RL);
    SEAM(24);
    if (IN(25)) { EpiG<1> e = mk_epi<1>(T, FF); run_gemm<1>(lds, U, W1T + (size_t)2 * FF * DM, RL, FF, DM, e); }
    SEAM(25);
    if (IN(26)) { EpiG<2> e = mk_epi<2>(Y, DM); run_gemm<2>(lds, T, W2T + (size_t)2 * DM * FF, RL, DM, FF, e); }
    SEAM(26);
    if (IN(27)) ph_resid(Y, normg + (2 * 4 + 3) * DM, mods + (size_t)2 * 5 * NMOD, 5, x, cin, H, false, H, true, normg + (3 * 4 + 0) * DM, mods + (size_t)3 * 5 * NMOD, 0, 1, U, RL);
    SEAM(27);
    if (IN(28)) { EpiG<0> e = mk_epi<0>(ws + WS_ZT, RL); run_gemm<0>(lds, (const bf16_t*)(ws + WS_HYIN), U, 6144, RL, DM, e); }
    SEAM(28);
    if (IN(29)) ph_hyena(lds, (const bf16_t*)(ws + WS_ZT), args.in[I_HYCW], args.in[I_HYCB], a3T, args.in[I_HYW4], args.in[I_HYB4], args.in[I_HYDECAY], args.in[I_HYSKIP], tw,
                         (float*)(ws + WS_Y1S), (bf16_t*)(ws + WS_Y2T));
    SEAM(29);
    if (IN(30)) ph_transpose(lds, (const bf16_t*)(ws + WS_Y2T), O);
    SEAM(30);
    if (IN(31)) { EpiG<2> e = mk_epi<2>(Y, DM); run_gemm<2>(lds, O, (const bf16_t*)(ws + WS_HYO), RL, DM, DM, e); }
    SEAM(31);
    if (IN(32)) ph_resid(Y, normg + (3 * 4 + 1) * DM, mods + (size_t)3 * 5 * NMOD, 2, x, cin, H, false, H, true, normg + (3 * 4 + 2) * DM, mods + (size_t)3 * 5 * NMOD, 3, 4, U, RL);
    SEAM(32);
    if (IN(33)) { EpiG<1> e = mk_epi<1>(T, FF); run_gemm<1>(lds, U, W1T + (size_t)3 * FF * DM, RL, FF, DM, e); }
    SEAM(33);
    if (IN(34)) { EpiG<2> e = mk_epi<2>(Y, DM); run_gemm<2>(lds, T, W2T + (size_t)3 * DM * FF, RL, DM, FF, e); }
    SEAM(34);
    if (IN(35)) ph_resid(Y, normg + (3 * 4 + 3) * DM, mods + (size_t)3 * 5 * NMOD, 5, x, cin, H, false, args.out, false, nullptr, nullptr, 0, 0, nullptr, RL);
#undef IN
#undef SEAM
}

extern "C" void kernel_launch(void* const* d_in, const int* in_sizes, int n_in, void* d_out, int out_size, void* d_ws, size_t ws_size, hipStream_t stream) {
    static int grid = 0;
    if (grid == 0) {
        if (n_in != N_IN || ws_size < WS_END) { fprintf(stderr, "kernel_launch: expected %d inputs and >= %zu bytes of workspace, got %d / %zu\n", N_IN, (size_t)WS_END, n_in, ws_size); grid = -1; return; }
        int dev = 0, cus = 0, per_cu = 0;
        if (hipGetDevice(&dev) != hipSuccess || hipDeviceGetAttribute(&cus, hipDeviceAttributeMultiprocessorCount, dev) != hipSuccess) { grid = -1; return; }
        if (hipFuncSetAttribute((const void*)mk_fwd, hipFuncAttributeMaxDynamicSharedMemorySize, LDS_BYTES) != hipSuccess) { fprintf(stderr, "kernel_launch: hipFuncSetAttribute failed\n"); grid = -1; return; }
        if (hipOccupancyMaxActiveBlocksPerMultiprocessor(&per_cu, (const void*)mk_fwd, NTHREADS, LDS_BYTES) != hipSuccess || per_cu < 1) { fprintf(stderr, "kernel_launch: occupancy query says %d blocks per CU\n", per_cu); }
        (void)hipGetLastError();
        grid = cus;
    }
    if (grid < 0) return;
    (void)hipMemsetAsync((char*)d_ws + WS_CTL, 0, 16384, stream);
    Args a{};
    for (int i = 0; i < N_IN; ++i) a.in[i] = (const float*)d_in[i];
    a.out = (float*)d_out; a.ws = (unsigned char*)d_ws;
#if MK_ONE_LAUNCH
    a.ph_lo = 0; a.ph_hi = N_PHASES;
    hipLaunchKernelGGL(mk_fwd, dim3(grid), dim3(NTHREADS), LDS_BYTES, stream, a);
#else
    for (int p = 0; p < N_PHASES; ++p) { a.ph_lo = p; a.ph_hi = p + 1; hipLaunchKernelGGL(mk_fwd, dim3(grid), dim3(NTHREADS), LDS_BYTES, stream, a); }
#endif
}
```

```cpp
#include <hip/hip_runtime.h>
#include <stdint.h>
#include <stdio.h>

#ifndef MK_ONE_LAUNCH
#define MK_ONE_LAUNCH 1
#endif

typedef unsigned short bf16_t;
typedef short bf16x8 __attribute__((ext_vector_type(8)));
typedef short s16x4 __attribute__((ext_vector_type(4)));
typedef float f32x4 __attribute__((ext_vector_type(4)));
typedef float f32x2 __attribute__((ext_vector_type(2)));
typedef float f32x16 __attribute__((ext_vector_type(16)));
typedef unsigned u32x4 __attribute__((ext_vector_type(4)));
typedef unsigned u32x2 __attribute__((ext_vector_type(2)));
#define LAS __attribute__((address_space(3)))

constexpr int DM = 2048, NB = 4, SEQ = 4096, CTX = 256, FF = 8192;
constexpr int RL = NB * SEQ;
constexpr int RA = RL + NB * CTX;
constexpr int NMOD = 6 * DM;
constexpr float RMS_EPS = 1e-6f;
constexpr int NTHREADS = 512, NWAVES = 8;
constexpr int LDS_BYTES = 147456 + 512 + 8192;
constexpr int LDS_MISC = 147456;
constexpr int LDS_TWL  = 147456 + 512;

constexpr size_t al256(size_t x) { return (x + 255) & ~(size_t)255; }
constexpr size_t WS_CTL   = 0;
constexpr size_t WS_MODS  = 16384;
constexpr size_t WS_ROPEA = WS_MODS + al256((size_t)4 * 5 * NMOD * 4);
constexpr size_t WS_ROPEC = WS_ROPEA + (size_t)4096 * 64 * 8;
constexpr size_t WS_TW    = WS_ROPEC + (size_t)4096 * 32 * 8;
constexpr size_t WS_A3T   = WS_TW + (size_t)8192 * 8;
constexpr size_t WS_W4TB  = WS_A3T + (size_t)4096 * 256 * 2;
constexpr size_t WS_W1T   = WS_W4TB + (size_t)8192 * 256 * 2;
constexpr size_t WS_W2T   = WS_W1T + (size_t)4 * FF * DM * 2;
constexpr size_t WS_QKVT  = WS_W2T + (size_t)4 * FF * DM * 2;
constexpr size_t WS_SWOT  = WS_QKVT + (size_t)3072 * DM * 2;
constexpr size_t WS_MLIN  = WS_SWOT + (size_t)DM * DM * 2;
constexpr size_t WS_MLO   = WS_MLIN + (size_t)6400 * DM * 2;
constexpr size_t WS_MAIN  = WS_MLO + (size_t)DM * DM * 2;
constexpr size_t WS_MUQ   = WS_MAIN + (size_t)1280 * DM * 2;
constexpr size_t WS_MUKV  = WS_MUQ + (size_t)3072 * 512 * 2;
constexpr size_t WS_MAO   = WS_MUKV + (size_t)4096 * 512 * 2;
constexpr size_t WS_HYIN  = WS_MAO + (size_t)DM * DM * 2;
constexpr size_t WS_HYO   = WS_HYIN + (size_t)6144 * DM * 2;
constexpr size_t WS_H     = WS_HYO + (size_t)DM * DM * 2;
constexpr size_t WS_U     = WS_H + (size_t)RA * DM * 4;
constexpr size_t WS_Y     = WS_U + (size_t)RA * DM * 2;
constexpr size_t WS_YP    = WS_Y + (size_t)RA * DM * 2;
constexpr size_t WS_O     = WS_Y + (size_t)RA * DM * 4;
constexpr size_t WS_BIG   = WS_O + (size_t)RA * DM * 2;
constexpr size_t WS_T     = WS_BIG;
constexpr size_t WS_QKV   = WS_BIG;
constexpr size_t WS_Z1    = WS_BIG;
constexpr size_t WS_DC    = WS_Z1 + (size_t)RA * 6400 * 2;
constexpr size_t WS_DN    = WS_DC + (size_t)1088 * 32768 * 4;
constexpr size_t WS_AC    = WS_DN + (size_t)1088 * 128 * 4;
constexpr size_t WS_CS    = WS_AC + 8192;
constexpr size_t WS_NS    = WS_CS + (size_t)1088 * 32768 * 2;
constexpr size_t WS_HD    = WS_NS + (size_t)1088 * 128 * 4;
constexpr size_t WS_GB    = WS_HD + (size_t)2 * RA * DM * 2;
constexpr size_t WS_ML_END = WS_GB + (size_t)1088 * 512 * 4;
constexpr size_t WS_Z2    = WS_BIG;
constexpr size_t WS_ZQ    = WS_Z2 + (size_t)RA * 1280 * 4;
constexpr size_t WS_ZKV   = WS_ZQ + (size_t)RA * 512 * 2;
constexpr size_t WS_KR    = WS_ZKV + (size_t)RA * 512 * 2;
constexpr size_t WS_Q2    = WS_KR + (size_t)RA * 64 * 2;
constexpr size_t WS_KV    = WS_Q2 + (size_t)RL * 3072 * 2;
constexpr size_t WS_ZT    = WS_BIG;
constexpr size_t WS_Y2T   = WS_ZT + (size_t)6144 * RL * 2;
constexpr size_t WS_F     = WS_Y2T + (size_t)DM * RL * 2;
constexpr size_t WS_Y1S   = WS_F + (size_t)8192 * 4096 * 4;
constexpr size_t WS_END   = WS_ML_END;

__device__ __forceinline__ unsigned cvt_pk_bf16(float lo, float hi) { unsigned r; asm volatile("v_cvt_pk_bf16_f32 %0, %1, %2" : "=v"(r) : "v"(lo), "v"(hi)); return r; }
__device__ __forceinline__ bf16_t f2bf(float x) { return (bf16_t)(cvt_pk_bf16(x, 0.f) & 0xffffu); }
__device__ __forceinline__ float bf2f(bf16_t b) { return __uint_as_float(((unsigned)b) << 16); }
__device__ __forceinline__ float bflo(unsigned w) { return __uint_as_float(w << 16); }
__device__ __forceinline__ float bfhi(unsigned w) { return __uint_as_float(w & 0xffff0000u); }
__device__ __forceinline__ int crow(int r, int hi) { return (r & 3) + 8 * (r >> 2) + 4 * hi; }
__device__ __forceinline__ float wave_sum(float v) {
#pragma unroll
    for (int o = 32; o >= 1; o >>= 1) v += __shfl_xor(v, o);
    return v;
}

#define XB_TMO      128
#define XB_XCNT(j)  (256  + 64 * (j))
#define XB_XSUB(j)  (1280 + 64 * (j))
#define XB_XGEN(j)  (2304 + 64 * (j))
#define XB_TOP      3328
#define XB_TOPGEN   3392
#define XCD_BAR_WORDS 3456
#define XB_SPIN_CAP (1u << 18)

__device__ __forceinline__ unsigned xb_ld(unsigned* p)              { return __hip_atomic_load(p, __ATOMIC_RELAXED, __HIP_MEMORY_SCOPE_AGENT); }
__device__ __forceinline__ unsigned xb_add(unsigned* p, unsigned v) { return __hip_atomic_fetch_add(p, v, __ATOMIC_RELAXED, __HIP_MEMORY_SCOPE_AGENT); }
__device__ __forceinline__ unsigned xb_xcc_id() { return (unsigned)__builtin_amdgcn_s_getreg((3 << 11) | 20) & 0xFu; }
#define XB_SPIN(cond, bar) do { unsigned _sp = 0; while (cond) { __builtin_amdgcn_s_sleep(1); \
    if ((++_sp & 255u) == 0u) { if (xb_ld(&(bar)[XB_TMO])) break; if (_sp > XB_SPIN_CAP) { atomicAdd(&(bar)[XB_TMO], 1u); break; } } } } while (0)

struct XcdBarrier {
    unsigned* bar; unsigned x;
    volatile LAS unsigned* st;
};

__device__ __forceinline__ XcdBarrier xcd_barrier_post(unsigned* bar, volatile LAS unsigned* st) {
    XcdBarrier b; b.bar = bar; b.x = xb_xcc_id(); b.st = st;
    if (threadIdx.x == 0) (void)xb_add(&bar[XB_XCNT(b.x)], 1u);
    return b;
}
__device__ __forceinline__ void xcd_barrier_complete(unsigned* bar, unsigned x, unsigned& nloc, unsigned& nx) {
    const unsigned G = gridDim.x * gridDim.y * gridDim.z;
    unsigned sum, cnt, mine, sp = 0u;
    for (;;) {
        sum = 0u; cnt = 0u; mine = 0u;
#pragma unroll
        for (unsigned j = 0; j < 16; ++j) { const unsigned c = xb_ld(&bar[XB_XCNT(j)]); sum += c; cnt += (c > 0u) ? 1u : 0u; mine = (j == x) ? c : mine; }
        if (sum == G) break;
        __builtin_amdgcn_s_sleep(1);
        if ((++sp & 255u) == 0u) { if (xb_ld(&bar[XB_TMO])) break; if (sp > XB_SPIN_CAP) { atomicAdd(&bar[XB_TMO], 1u); break; } }
    }
    nloc = mine > 0u ? mine : 1u; nx = cnt > 0u ? cnt : 1u;
}

__device__ __forceinline__ void xcd_barrier(const XcdBarrier& b) {
    asm volatile("s_waitcnt vmcnt(0)" ::: "memory");
    __syncthreads();
    if (threadIdx.x == 0) {
        unsigned* bar = b.bar;
        __builtin_amdgcn_s_waitcnt(0);
        unsigned nloc = b.st[0], nx = b.st[1];
        if (nloc == 0u) { xcd_barrier_complete(bar, b.x, nloc, nx); b.st[0] = nloc; b.st[1] = nx; }
        const unsigned old = xb_add(&bar[XB_XSUB(b.x)], 1u);
        const unsigned gen = old / nloc;
        if (old + 1u == (gen + 1u) * nloc) {
            __builtin_amdgcn_fence(__ATOMIC_RELEASE, "agent");
            asm volatile("s_waitcnt vmcnt(0)" ::: "memory");
            const unsigned og = xb_add(&bar[XB_TOP], 1u);
            const unsigned tg = og / nx;
            if (og + 1u == (tg + 1u) * nx) xb_add(&bar[XB_TOPGEN], 1u);
            else XB_SPIN(xb_ld(&bar[XB_TOPGEN]) == tg, bar);
            __builtin_amdgcn_fence(__ATOMIC_ACQUIRE, "agent");
            xb_add(&bar[XB_XGEN(b.x)], 1u);
            asm volatile("s_waitcnt vmcnt(0)" ::: "memory");
        } else {
            XB_SPIN(xb_ld(&bar[XB_XGEN(b.x)]) == gen, bar);
            __builtin_amdgcn_fence(__ATOMIC_ACQUIRE, "agent");
            asm volatile("s_waitcnt vmcnt(0)" ::: "memory");
        }
    }
    __syncthreads();
}

namespace pg8 {
#define PG8_LAS __attribute__((address_space(3)))
typedef unsigned short bf16_t;
typedef short bf16x8 __attribute__((ext_vector_type(8)));
typedef float f32x4 __attribute__((ext_vector_type(4)));
typedef unsigned u32x4 __attribute__((ext_vector_type(4)));
constexpr int BM = 256, BK = 64, HALF = 128, HTB = HALF * BK * 2  , STAGE_BYTES = 8 * HTB, NXCD = 8, WGM = 8;

__host__ __device__ __forceinline__ int lds_byte(int r, int c) { const int st = (r >> 4) * 2 + (c >> 5), rr = r & 15, cc = c & 31, ob = rr * 64 + cc * 2; return st * 1024 + (ob ^ (((ob >> 9) & 1) << 5)); }
__host__ __device__ __forceinline__ void stage_rc(int b, int& R, int& C) { const int st = b / 1024, sb = b % 1024, swz = sb ^ (((sb >> 9) & 1) << 5); R = (st >> 1) * 16 + swz / 64; C = (st & 1) * 32 + (swz % 64) / 2; }
__host__ __device__ __forceinline__ int perm32(int rho) { const int n = rho >> 4, i = rho & 15; return 8 * (i >> 2) + 4 * n + (i & 3); }

struct Unit { int pm, pn, ks; };
struct Gemm { const bf16_t* A; const bf16_t* Bt; int M, N, K, ld; };

struct StaticOrder {
    int nM, nN, nwg, G, c, wgm;
    __host__ __device__ void init(int M, int N, int G_, int c_, int wgm_ = WGM) { nM = M / BM; nN = N / BM; nwg = nM * nN; G = G_; c = c_; wgm = wgm_; }
    __host__ __device__ bool next(int i, Unit& u) const {
        const long L = (long)i * G + c; if (L >= nwg) return false;
        int wgid = (int)L; { const int q = nwg / NXCD, r = nwg % NXCD, xcd = wgid % NXCD, off = wgid / NXCD; wgid = (xcd < r ? xcd * (q + 1) : r * (q + 1) + (xcd - r) * q) + off; }
        const int nig = wgm * nN, gid = wgid / nig, fm = gid * wgm, gsz = (nM - fm) < wgm ? (nM - fm) : wgm;
        u.pm = fm + ((wgid % nig) % gsz); u.pn = (wgid % nig) / gsz; u.ks = 0; return true;
    }
    __device__ __forceinline__ void a_ready(const Unit&) const {}
    __device__ __forceinline__ void done(const Unit&) const {}
};
__device__ __forceinline__ unsigned cvt_pk_bf16(float lo, float hi) { unsigned r; asm volatile("v_cvt_pk_bf16_f32 %0, %1, %2" : "=v"(r) : "v"(lo), "v"(hi)); return r; }

template <class Epi, class Sched, bool STAMP = false, int AUXA = 0>
__device__ __forceinline__ void gemm_phase(PG8_LAS unsigned char* lds, const Gemm g, const Sched& S, const Epi& E, unsigned long long* stamps) {
    const int tid = threadIdx.x, wid = __builtin_amdgcn_readfirstlane(tid >> 6), lane = tid & 63, wr = wid >> 2, wc = wid & 3, fr = lane & 15, fq = lane >> 4;
    const int K = g.K, ld = g.ld, nt = K / BK;
    int ts_lo = 0, ts_hi = 0, nts = 0; const unsigned long long rt_entry = STAMP ? (unsigned long long)wall_clock64() : 0ull;
#define PG8_STAMP() do { if (STAMP && wid == 0 && nts < 64) { const unsigned long long _c = (unsigned long long)clock64(); \
        ts_lo = (lane == nts) ? (int)(unsigned)_c : ts_lo; ts_hi = (lane == nts) ? (int)(unsigned)(_c >> 32) : ts_hi; ++nts; } } while (0)
    PG8_STAMP();
    unsigned voffA[2], voffB[2];
#pragma unroll
    for (int i = 0; i < 2; ++i) { int R, C; stage_rc(tid * 16 + i * 8192, R, C); const int Rb = Epi::PERM ? ((R & ~31) + perm32(R & 31)) : R;
        voffA[i] = (unsigned)(R * ld + C) * 2u; voffB[i] = (unsigned)(Rb * ld + C) * 2u; }
    const size_t kstep = (size_t)(BK * 2);
    const size_t hstep = (size_t)HALF * ld * 2;
    const size_t tstep = 2 * hstep;
    const unsigned ldsw = (unsigned)wid * 1024u;
    const int aoff = lds_byte(wr * 64 + fr, fq * 8), boff = lds_byte(wc * 32 + fr, fq * 8);
#define PG8_SA(b, h) (((b) * 2 + (h)) * HTB)
#define PG8_SB(b, h) ((4 + (b) * 2 + (h)) * HTB)
#define PG8_STAGE(bufoff, gbase, voff) do { _Pragma("unroll") for (int _i = 0; _i < 2; ++_i) \
        __builtin_amdgcn_global_load_lds((const unsigned*)((const char*)(gbase) + (voff)[_i]), (PG8_LAS unsigned*)(lds + (bufoff) + ldsw + _i * 8192), 16, 0, 0); } while (0)
#define PG8_STAGEA(bufoff, gbase, voff) do { _Pragma("unroll") for (int _i = 0; _i < 2; ++_i) \
        __builtin_amdgcn_global_load_lds((const unsigned*)((const char*)(gbase) + (voff)[_i]), (PG8_LAS unsigned*)(lds + (bufoff) + ldsw + _i * 8192), 16, 0, AUXA); } while (0)
#define PG8_LDA(dst, b, h) do { _Pragma("unroll") for (int m = 0; m < 4; ++m) _Pragma("unroll") for (int k = 0; k < 2; ++k) dst[m][k] = *(const PG8_LAS bf16x8*)(lds + PG8_SA(b, h) + aoff + m * 2048 + k * 1024); } while (0)
#define PG8_LDB(dst, b, h) do { _Pragma("unroll") for (int n = 0; n < 2; ++n) _Pragma("unroll") for (int k = 0; k < 2; ++k) dst[n][k] = *(const PG8_LAS bf16x8*)(lds + PG8_SB(b, h) + boff + n * 2048 + k * 1024); } while (0)
#define PG8_MMA(ai, bj, At, Bt) do { __builtin_amdgcn_s_setprio(1); _Pragma("unroll") for (int m = 0; m < 4; ++m) _Pragma("unroll") for (int n = 0; n < 2; ++n) _Pragma("unroll") for (int k = 0; k < 2; ++k) \
        acc[ai][bj][m][n] = __builtin_amdgcn_mfma_f32_16x16x32_bf16(Bt[n][k], At[m][k], acc[ai][bj][m][n], 0, 0, 0); __builtin_amdgcn_s_setprio(0); } while (0)
#define PG8_WAIT_V(n) asm volatile("s_waitcnt vmcnt(" #n ")" ::: "memory")
#define PG8_WAIT_L(n) asm volatile("s_waitcnt lgkmcnt(" #n ")" ::: "memory")
#define PG8_BAR __builtin_amdgcn_s_barrier()
#define PG8_SCHED __builtin_amdgcn_sched_barrier(0)
    Unit cur, nxt; int ui = 0;
    if (!S.next(0, cur)) return;
    f32x4 acc[2][2][4][2];
#pragma unroll
    for (int a = 0; a < 2; ++a)
#pragma unroll
        for (int b = 0; b < 2; ++b)
#pragma unroll
            for (int m = 0; m < 4; ++m)
#pragma unroll
                for (int n = 0; n < 2; ++n) acc[a][b][m][n] = (f32x4){0.f, 0.f, 0.f, 0.f};
    bf16x8 At[4][2], B0[2][2], B1[2][2];
    const size_t sstep = (size_t)K * 2;
    const char* cA = (const char*)g.A + (size_t)cur.pm * tstep + (size_t)cur.ks * sstep; const char* cB = (const char*)g.Bt + (size_t)cur.pn * tstep + (size_t)cur.ks * sstep;
    S.a_ready(cur);
    PG8_STAGE(PG8_SB(0, 0), cB, voffB); PG8_STAGEA(PG8_SA(0, 0), cA, voffA); PG8_STAGE(PG8_SB(0, 1), cB + hstep, voffB); PG8_STAGEA(PG8_SA(0, 1), cA + hstep, voffA);
    if (wr == 1) PG8_BAR;
    PG8_WAIT_V(4); PG8_BAR;
    PG8_STAGE(PG8_SB(1, 0), cB + kstep, voffB); PG8_STAGEA(PG8_SA(1, 0), cA + kstep, voffA); PG8_STAGE(PG8_SB(1, 1), cB + hstep + kstep, voffB);
    PG8_WAIT_V(6); PG8_BAR;
    PG8_STAMP();
    for (;;) {
        const bool has_next = S.next(ui + 1, nxt);
        const char* nA = has_next ? (const char*)g.A + (size_t)nxt.pm * tstep + (size_t)nxt.ks * sstep : cA; const char* nB = has_next ? (const char*)g.Bt + (size_t)nxt.pn * tstep + (size_t)nxt.ks * sstep : cB;
        for (int t = 0; t < nt; t += 2) {
            const bool last = (t == nt - 2);
            const char* a1 = cA + (size_t)(t + 1) * kstep;
            const char* a2 = last ? nA : cA + (size_t)(t + 2) * kstep; const char* b2 = last ? nB : cB + (size_t)(t + 2) * kstep;
            const char* a3 = a2 + kstep; const char* b3 = b2 + kstep;
            if (last && has_next) S.a_ready(nxt);
            PG8_LDB(B0, 0, 0); PG8_SCHED; PG8_LDA(At, 0, 0); PG8_STAGEA(PG8_SA(1, 1), a1 + hstep, voffA);
            PG8_WAIT_L(8); PG8_BAR; PG8_WAIT_L(0); PG8_MMA(0, 0, At, B0); PG8_BAR; PG8_SCHED;
            PG8_LDB(B1, 0, 1); PG8_STAGE(PG8_SB(0, 0), b2, voffB);
            PG8_BAR; PG8_WAIT_L(0); PG8_MMA(0, 1, At, B1); PG8_BAR;
            PG8_LDA(At, 0, 1); PG8_STAGEA(PG8_SA(0, 0), a2, voffA);
            PG8_BAR; PG8_WAIT_L(0); PG8_MMA(1, 0, At, B0); PG8_BAR; PG8_SCHED;
            PG8_STAGE(PG8_SB(0, 1), b2 + hstep, voffB);
            PG8_WAIT_V(6); PG8_BAR; PG8_MMA(1, 1, At, B1); PG8_BAR;
            PG8_LDB(B0, 1, 0); PG8_SCHED; PG8_LDA(At, 1, 0); PG8_STAGEA(PG8_SA(0, 1), a2 + hstep, voffA);
            PG8_WAIT_L(8); PG8_BAR; PG8_WAIT_L(0); PG8_MMA(0, 0, At, B0); PG8_BAR; PG8_SCHED;
            PG8_LDB(B1, 1, 1); PG8_STAGE(PG8_SB(1, 0), b3, voffB);
            PG8_BAR; PG8_WAIT_L(0); PG8_MMA(0, 1, At, B1); PG8_BAR;
            PG8_LDA(At, 1, 1); PG8_STAGEA(PG8_SA(1, 0), a3, voffA);
            PG8_BAR; PG8_WAIT_L(0); PG8_MMA(1, 0, At, B0); PG8_BAR; PG8_SCHED;
            PG8_STAGE(PG8_SB(1, 1), b3 + hstep, voffB);
            PG8_WAIT_V(6); PG8_BAR; PG8_MMA(1, 1, At, B1); PG8_BAR;
        }
        PG8_STAMP();
        if constexpr (!Epi::AFTER_DRAIN) { E(acc, cur, wr, wc, fr, fq); S.done(cur); }
        PG8_STAMP();
        if (!has_next) break;
#pragma unroll
        for (int a = 0; a < 2; ++a)
#pragma unroll
            for (int b = 0; b < 2; ++b)
#pragma unroll
                for (int m = 0; m < 4; ++m)
#pragma unroll
                    for (int n = 0; n < 2; ++n) acc[a][b][m][n] = (f32x4){0.f, 0.f, 0.f, 0.f};
        cur = nxt; cA = nA; cB = nB; ++ui;
    }
    PG8_WAIT_V(0);
    if (wr == 0) PG8_BAR;
    PG8_BAR;
    if constexpr (Epi::AFTER_DRAIN) { E.fused(acc, cur, wr, wc, fr, fq, lds, wid, lane); S.done(cur); }
    PG8_STAMP();
    if (STAMP && wid == 0) { stamps[lane] = lane < nts ? (((unsigned long long)(unsigned)ts_hi << 32) | (unsigned)ts_lo) : 0ull;
        if (lane == 62) stamps[62] = rt_entry; if (lane == 63) stamps[63] = (unsigned long long)wall_clock64(); }
#undef PG8_STAMP
#undef PG8_SA
#undef PG8_SB
#undef PG8_STAGE
#undef PG8_STAGEA
#undef PG8_LDA
#undef PG8_LDB
#undef PG8_MMA
#undef PG8_WAIT_V
#undef PG8_WAIT_L
#undef PG8_BAR
#undef PG8_SCHED
}
}

template <int MODE> struct EpiG {
    static constexpr bool PERM = true, AFTER_DRAIN = false;
    void* out; int ldc;
    const f32x2* rope; int head_w, rope_off, rope_cols, tab_stride, rope_rows;
    __device__ __forceinline__ void operator()(const pg8::f32x4 (&acc)[2][2][4][2], const pg8::Unit& u, int wr, int wc, int fr, int fq) const {
        const int row0 = u.pm * 256 + wr * 64 + fr, col0 = u.pn * 256 + wc * 32 + 8 * fq;
#pragma unroll
        for (int ai = 0; ai < 2; ++ai)
#pragma unroll
            for (int m = 0; m < 4; ++m) {
                const int row = row0 + ai * 128 + m * 16;
#pragma unroll
                for (int bj = 0; bj < 2; ++bj) {
                    const int col = col0 + bj * 128;
                    f32x4 v0 = acc[ai][bj][m][0], v1 = acc[ai][bj][m][1];
                    if (MODE == 0) {
                        if (rope != nullptr && col < rope_cols && row < rope_rows) {
                            const int hc = col % head_w;
                            if (hc >= rope_off) {
                                const f32x2* tab = rope + (size_t)(row & 4095) * tab_stride + ((hc - rope_off) >> 1);
                                const f32x2 c0 = tab[0], c1 = tab[1], c2 = tab[2], c3 = tab[3];
                                f32x4 w0, w1;
                                w0[0] = v0[0] * c0.x - v0[1] * c0.y; w0[1] = v0[1] * c0.x + v0[0] * c0.y;
                                w0[2] = v0[2] * c1.x - v0[3] * c1.y; w0[3] = v0[3] * c1.x + v0[2] * c1.y;
                                w1[0] = v1[0] * c2.x - v1[1] * c2.y; w1[1] = v1[1] * c2.x + v1[0] * c2.y;
                                w1[2] = v1[2] * c3.x - v1[3] * c3.y; w1[3] = v1[3] * c3.x + v1[2] * c3.y;
                                v0 = w0; v1 = w1;
                            }
                        }
                    }
                    if (MODE == 1) {
#pragma unroll
                        for (int j = 0; j < 4; ++j) { float a = fmaxf(v0[j], 0.f), b = fmaxf(v1[j], 0.f); v0[j] = a * a; v1[j] = b * b; }
                    }
                    if (MODE == 2) {
                        float* rp = (float*)out + (size_t)row * ldc + col;
                        *(f32x4*)rp = v0; *(f32x4*)(rp + 4) = v1;
                    } else {
                        u32x4 w; w.x = cvt_pk_bf16(v0[0], v0[1]); w.y = cvt_pk_bf16(v0[2], v0[3]); w.z = cvt_pk_bf16(v1[0], v1[1]); w.w = cvt_pk_bf16(v1[2], v1[3]);
                        *(u32x4*)((bf16_t*)out + (size_t)row * ldc + col) = w;
                    }
                }
            }
    }
};
template <int MODE, int AUXA = 0, int WGMV = 8> __device__ __forceinline__ void run_gemm(LAS unsigned char* lds, const bf16_t* A, const bf16_t* Bt, int M, int N, int K, const EpiG<MODE>& E, int vbid) {
    pg8::Gemm g{A, Bt, M, N, K, K};
    pg8::StaticOrder S; S.init(M, N, (int)gridDim.x, vbid, WGMV);
    pg8::gemm_phase<EpiG<MODE>, pg8::StaticOrder, false, AUXA>((PG8_LAS unsigned char*)lds, g, S, E, nullptr);
}
struct SplitOrder {
    int nM, nN, nS, G, c;
    __device__ __forceinline__ bool next(int i, pg8::Unit& u) const {
        const int L = i * G + c; if (L >= nM * nN * nS) return false;
        u.ks = L % nS; const int t = L / nS; u.pn = t % nN; u.pm = t / nN; return true;
    }
    __device__ __forceinline__ void a_ready(const pg8::Unit&) const {}
    __device__ __forceinline__ void done(const pg8::Unit&) const {}
};
struct EpiPart {
    static constexpr bool PERM = true, AFTER_DRAIN = false;
    bf16_t* out; int ldc; size_t split_stride;
    __device__ __forceinline__ void operator()(const pg8::f32x4 (&acc)[2][2][4][2], const pg8::Unit& u, int wr, int wc, int fr, int fq) const {
        const int row0 = u.pm * 256 + wr * 64 + fr, col0 = u.pn * 256 + wc * 32 + 8 * fq;
        bf16_t* base = out + (size_t)u.ks * split_stride;
#pragma unroll
        for (int ai = 0; ai < 2; ++ai)
#pragma unroll
            for (int m = 0; m < 4; ++m)
#pragma unroll
                for (int bj = 0; bj < 2; ++bj) {
                    bf16_t* rp = base + (size_t)(row0 + ai * 128 + m * 16) * ldc + col0 + bj * 128;
                    const f32x4 v0 = acc[ai][bj][m][0], v1 = acc[ai][bj][m][1];
                    u32x4 w; w.x = cvt_pk_bf16(v0[0], v0[1]); w.y = cvt_pk_bf16(v0[2], v0[3]); w.z = cvt_pk_bf16(v1[0], v1[1]); w.w = cvt_pk_bf16(v1[2], v1[3]);
                    *(u32x4*)rp = w;
                }
    }
};
__device__ __forceinline__ void run_gemm_split(LAS unsigned char* lds, const bf16_t* A, const bf16_t* Bt, int M, int N, int Kfull, int nS, bf16_t* P, int vbid) {
    pg8::Gemm g{A, Bt, M, N, Kfull / nS, Kfull};
    SplitOrder S; S.nM = M / 256; S.nN = N / 256; S.nS = nS; S.G = (int)gridDim.x; S.c = vbid;
    EpiPart E; E.out = P; E.ldc = N; E.split_stride = (size_t)M * N;
    pg8::gemm_phase<EpiPart, SplitOrder, false>((PG8_LAS unsigned char*)lds, g, S, E, nullptr);
}
template <int MODE> __device__ __forceinline__ EpiG<MODE> mk_epi(void* out, int ldc) { EpiG<MODE> e; e.out = out; e.ldc = ldc; e.rope = nullptr; e.head_w = 128; e.rope_off = 0; e.rope_cols = 0; e.tab_stride = 0; e.rope_rows = 0; return e; }

struct EpiFilt {
    static constexpr bool PERM = true, AFTER_DRAIN = false;
    bf16_t* F; const float* b4; const float* decay;
    __device__ __forceinline__ void operator()(const pg8::f32x4 (&acc)[2][2][4][2], const pg8::Unit& u, int wr, int wc, int fr, int fq) const {
        const int row0 = u.pm * 256 + wr * 64 + fr, col0 = u.pn * 256 + wc * 32 + 8 * fq;
#pragma unroll
        for (int ai = 0; ai < 2; ++ai)
#pragma unroll
            for (int m = 0; m < 4; ++m) {
                const int row = row0 + ai * 128 + m * 16;
                __builtin_amdgcn_sched_barrier(0);
                const float bb = b4[row], dd = -fabsf(decay[row]) * (1.0f / 4095.0f), st = __expf(dd);
#pragma unroll
                for (int bj = 0; bj < 2; ++bj) {
                    const int l0 = col0 + bj * 128;
                    f32x4 v0 = acc[ai][bj][m][0], v1 = acc[ai][bj][m][1];
                    float w = __expf((float)l0 * dd);
#pragma unroll
                    for (int e = 0; e < 4; ++e) { v0[e] = (v0[e] + bb) * w; w *= st; }
#pragma unroll
                    for (int e = 0; e < 4; ++e) { v1[e] = (v1[e] + bb) * w; w *= st; }
                    u32x4 pk; pk.x = cvt_pk_bf16(v0[0], v0[1]); pk.y = cvt_pk_bf16(v0[2], v0[3]); pk.z = cvt_pk_bf16(v1[0], v1[1]); pk.w = cvt_pk_bf16(v1[2], v1[3]);
                    *(u32x4*)(F + (size_t)row * 4096 + l0) = pk;
                }
            }
    }
};
__device__ __forceinline__ void run_gemm_filt(LAS unsigned char* lds, const bf16_t* W4TB, const bf16_t* A3B, bf16_t* F, const float* b4, const float* decay, int vbid) {
    pg8::Gemm g{W4TB, A3B, 8192, 4096, 256, 256};
    pg8::StaticOrder S; S.init(8192, 4096, (int)gridDim.x, vbid);
    EpiFilt E; E.F = F; E.b4 = b4; E.decay = decay;
    pg8::gemm_phase<EpiFilt, pg8::StaticOrder, false>((PG8_LAS unsigned char*)lds, g, S, E, nullptr);
}

__device__ __forceinline__ int wmap(int kind, int n, int Nsrc) {
    if (kind == 1) {
        if (n < 2560) { const int hb = n & ~127, j = n & 127; return hb + ((j & 1) ? 64 : 0) + (j >> 1); }
        return n;
    }
    if (kind == 2) {
        if (n < 1024) return n;
        if (n < 1088) { const int j = n - 1024; return 1024 + ((j & 1) ? 32 : 0) + (j >> 1); }
        return -1;
    }
    if (kind == 3) {
        const int hd = n / 192, j = n - hd * 192;
        if (j < 128) return n;
        const int jj = j - 128; return hd * 192 + 128 + ((jj & 1) ? 32 : 0) + (jj >> 1);
    }
    return n < Nsrc ? n : -1;
}
__device__ __forceinline__ void conv_weight(LAS unsigned char* lds, const float* __restrict__ src, bf16_t* __restrict__ dst, int K, int Nsrc, int Ndst, int kind, int nscale, float scale, int rank, int nwg) {
    LAS float* tile = (LAS float*)lds;
    const int tid = threadIdx.x, tilesN4 = Ndst / 256, tilesK = K / 64, ngrp = tilesN4 * tilesK;
    const int j = tid & 63, i0 = tid >> 6;
    float v[4][8];
#define CW_LOAD(g_) do { const int tn4_ = (g_) % tilesN4, tk_ = (g_) / tilesN4; \
        _Pragma("unroll") for (int q_ = 0; q_ < 4; ++q_) { const int n_ = tn4_ * 256 + q_ * 64 + j, sc_ = wmap(kind, n_, Nsrc); const float mul_ = (n_ < nscale) ? scale : 1.f; \
            _Pragma("unroll") for (int p_ = 0; p_ < 8; ++p_) v[q_][p_] = (sc_ >= 0) ? __builtin_nontemporal_load(src + (size_t)(tk_ * 64 + p_ * 8 + i0) * Nsrc + sc_) * mul_ : 0.f; } } while (0)
    int g = rank;
    if (g < ngrp) CW_LOAD(g);
    for (; g < ngrp; g += nwg) {
        const int tn4 = g % tilesN4, tk = g / tilesN4;
#pragma unroll
        for (int q = 0; q < 4; ++q)
#pragma unroll
            for (int p = 0; p < 8; ++p) tile[q * 4160 + (p * 8 + i0) * 65 + j] = v[q][p];
        __syncthreads();
        if (g + nwg < ngrp) CW_LOAD(g + nwg);
        {
            const int nn = tid >> 3, kg = tid & 7;
#pragma unroll
            for (int q = 0; q < 4; ++q) {
                float f[8];
#pragma unroll
                for (int e = 0; e < 8; ++e) f[e] = tile[q * 4160 + (kg * 8 + e) * 65 + nn];
                u32x4 w; w.x = cvt_pk_bf16(f[0], f[1]); w.y = cvt_pk_bf16(f[2], f[3]); w.z = cvt_pk_bf16(f[4], f[5]); w.w = cvt_pk_bf16(f[6], f[7]);
                *(u32x4*)(dst + (size_t)(tn4 * 256 + q * 64 + nn) * K + tk * 64 + kg * 8) = w;
            }
        }
        __syncthreads();
    }
#undef CW_LOAD
}

__device__ __forceinline__ bool tail_slot(int nunits, int vbid, int& rank, int& n) {
    const int G = (int)gridDim.x, rem = nunits % G;
    if (rem == 0) { rank = vbid; n = G; return true; }
    rank = vbid - rem; n = G - rem; return vbid >= rem;
}

__device__ __forceinline__ float silu_f(float x) { return x / (1.f + __expf(-x)); }

__device__ __forceinline__ void ph_mods(LAS unsigned char* lds, const float* __restrict__ c, const float* __restrict__ c_ctx, const float* __restrict__ ada_w, const float* __restrict__ ada_b, float* __restrict__ mods,
                                        int u_lo, int u_hi, int rank, int nwg) {
    if (u_lo + rank >= u_hi) return;
    LAS float* s = (LAS float*)lds;
    LAS float* red = (LAS float*)(lds + 5 * 2048 * 4);
    const int tid = threadIdx.x;
    for (int i = tid; i < 5 * 2048; i += NTHREADS) { const int m = i >> 11, k = i & 2047; s[i] = silu_f(m < 4 ? c[m * 2048 + k] : c_ctx[k]); }
    __syncthreads();
    const int cq = tid & 15, ks = tid >> 4;
    for (int u = u_lo + rank; u < u_hi; u += nwg) {
        const int layer = u / 192, cg = u % 192, col = cg * 64 + cq * 4;
        const float* wp = ada_w + ((size_t)layer * 2048 + ks * 64) * NMOD + col;
        f32x4 a0 = {0.f, 0.f, 0.f, 0.f}, a1 = a0, a2 = a0, a3 = a0, a4 = a0;
#pragma unroll 8
        for (int k = 0; k < 64; ++k) {
            const f32x4 w = __builtin_nontemporal_load((const f32x4*)(wp + (size_t)k * NMOD));
            const int kk = ks * 64 + k;
            a0 += w * s[kk]; a1 += w * s[2048 + kk]; a2 += w * s[4096 + kk]; a3 += w * s[6144 + kk]; a4 += w * s[8192 + kk];
        }
        *(LAS f32x4*)(red + (ks * 5 + 0) * 64 + cq * 4) = a0; *(LAS f32x4*)(red + (ks * 5 + 1) * 64 + cq * 4) = a1; *(LAS f32x4*)(red + (ks * 5 + 2) * 64 + cq * 4) = a2;
        *(LAS f32x4*)(red + (ks * 5 + 3) * 64 + cq * 4) = a3; *(LAS f32x4*)(red + (ks * 5 + 4) * 64 + cq * 4) = a4;
        __syncthreads();
        if (tid < 320) {
            const int m = tid >> 6, cc = tid & 63;
            float vsum = 0.f;
#pragma unroll 8
            for (int q = 0; q < 32; ++q) vsum += red[(q * 5 + m) * 64 + cc];
            mods[((size_t)layer * 5 + m) * NMOD + cg * 64 + cc] = vsum + ada_b[(size_t)layer * NMOD + cg * 64 + cc];
        }
        __syncthreads();
    }
}

__device__ __forceinline__ void ph_tables(f32x2* __restrict__ ropeA, f32x2* __restrict__ ropeC, f32x2* __restrict__ tw) {
    const int gt = blockIdx.x * NTHREADS + threadIdx.x, gn = gridDim.x * NTHREADS;
    for (int i = gt; i < 4096 * 64; i += gn) {
        const int t = i >> 6, p = i & 63, j = p & 31;
        const float inv = powf(10000.0f, -(float)j / 32.0f);
        const float pos = (float)((p < 32) ? (t >> 6) : (t & 63));
        const float ang = pos * inv;
        f32x2 v; v.x = cosf(ang); v.y = sinf(ang); ropeA[i] = v;
    }
    for (int i = gt; i < 4096 * 32; i += gn) {
        const int t = i >> 5, p = i & 31, j = p & 15;
        const float inv = powf(10000.0f, -(float)j / 16.0f);
        const float pos = (float)((p < 16) ? (t >> 6) : (t & 63));
        const float ang = pos * inv;
        f32x2 v; v.x = cosf(ang); v.y = sinf(ang); ropeC[i] = v;
    }
    for (int i = gt; i < 8192; i += gn) {
        float sn, cs; sincospif((float)i / 4096.0f, &sn, &cs);
        f32x2 v; v.x = cs; v.y = -sn; tw[i] = v;
    }
}

__device__ __forceinline__ void ph_hyena_feats(LAS unsigned char* lds, const float* __restrict__ w1, const float* __restrict__ b1, const float* __restrict__ w2, const float* __restrict__ b2,
                                               const float* __restrict__ w3, const float* __restrict__ b3, const float* __restrict__ freq, bf16_t* __restrict__ a3b) {
    const int tid = threadIdx.x, wave = tid >> 6, lane = tid & 63;
    LAS float* fa = (LAS float*)lds + wave * 128;
    LAS float* fb = fa + 64;
    const float fr = freq[lane];
    for (int l0 = blockIdx.x * 8; l0 < 4096; l0 += gridDim.x * 8) {
        const int l = l0 + wave;
        const float w = (6.283185307179586f / 4096.0f) * (float)l;
        float f = 0.f;
        if (lane == 0) f = (float)l * (1.0f / 4095.0f);
        else if (lane <= 32) {
            const int j = (lane - 1) & 15;
            const float band = 1e-4f + (float)j * ((15.0f - 1e-4f) / 15.0f);
            f = (lane <= 16) ? cosf(band * w) : -sinf(band * w);
        }
        __syncthreads();
        fa[lane] = f;
        __syncthreads();
        float acc = b1[lane];
        for (int i = 0; i < 33; ++i) acc += fa[i] * w1[i * 64 + lane];
        fb[lane] = sinf(fr * acc);
        __syncthreads();
        acc = b2[lane];
        for (int i = 0; i < 64; ++i) acc += fb[i] * w2[i * 64 + lane];
        fa[lane] = sinf(fr * acc);
        __syncthreads();
        acc = b3[lane];
        for (int i = 0; i < 64; ++i) acc += fa[i] * w3[i * 64 + lane];
        a3b[(size_t)l * 256 + lane] = f2bf(sinf(fr * acc));
        a3b[(size_t)l * 256 + 64 + lane] = 0; a3b[(size_t)l * 256 + 128 + lane] = 0; a3b[(size_t)l * 256 + 192 + lane] = 0;
    }
}

__device__ __forceinline__ void conv_w4(const float* __restrict__ w4, bf16_t* __restrict__ w4tb) {
    const int gt = blockIdx.x * NTHREADS + threadIdx.x, gn = gridDim.x * NTHREADS;
    for (int idx = gt; idx < 32 * 8192; idx += gn) {
        const int kg = idx >> 13, col = idx & 8191;
        u32x4 w = {0u, 0u, 0u, 0u};
        if (kg < 8) {
            float f[8];
#pragma unroll
            for (int q = 0; q < 8; ++q) f[q] = w4[(size_t)(kg * 8 + q) * 8192 + col];
            w.x = cvt_pk_bf16(f[0], f[1]); w.y = cvt_pk_bf16(f[2], f[3]); w.z = cvt_pk_bf16(f[4], f[5]); w.w = cvt_pk_bf16(f[6], f[7]);
        }
        *(u32x4*)(w4tb + (size_t)col * 256 + kg * 8) = w;
    }
}

__device__ __forceinline__ void ph_normmod(const float* __restrict__ xin, const float* __restrict__ cin, const float* __restrict__ h, bool from_input,
                                           const float* __restrict__ g, const float* __restrict__ mods, int kshift, int kscale, bf16_t* __restrict__ out, int nrows) {
    const int lane = threadIdx.x & 63, gw = blockIdx.x * NWAVES + (threadIdx.x >> 6), nw = gridDim.x * NWAVES;
    f32x4 vn[8];
#define NM_LOAD(r_) do { const int rr_ = (r_); const float* src_ = from_input ? (rr_ < RL ? xin + (size_t)rr_ * DM : cin + (size_t)(rr_ - RL) * DM) : h + (size_t)rr_ * DM; \
        _Pragma("unroll") for (int j_ = 0; j_ < 8; ++j_) vn[j_] = __builtin_nontemporal_load((const f32x4*)(src_ + j_ * 256 + lane * 4)); } while (0)
    if (gw < nrows) NM_LOAD(gw);
    for (int r = gw; r < nrows; r += nw) {
        const int b = r < RL ? (r >> 12) : 4;
        const float* sh = mods + (size_t)b * NMOD + kshift * DM;
        const float* sc = mods + (size_t)b * NMOD + kscale * DM;
        f32x4 v[8]; float ss = 0.f;
#pragma unroll
        for (int j = 0; j < 8; ++j) { v[j] = vn[j]; ss += v[j][0] * v[j][0] + v[j][1] * v[j][1] + v[j][2] * v[j][2] + v[j][3] * v[j][3]; }
        if (r + nw < nrows) NM_LOAD(r + nw);
        ss = wave_sum(ss);
        const float rstd = rsqrtf(ss * (1.0f / DM) + RMS_EPS);
#pragma unroll
        for (int j = 0; j < 8; ++j) {
            const int col = j * 256 + lane * 4;
            const f32x4 gg = *(const f32x4*)(g + col), s1 = *(const f32x4*)(sh + col), s2 = *(const f32x4*)(sc + col);
            f32x4 o;
#pragma unroll
            for (int e = 0; e < 4; ++e) o[e] = (v[j][e] * rstd * gg[e]) * (1.f + s2[e]) + s1[e];
            u32x2 w; w.x = cvt_pk_bf16(o[0], o[1]); w.y = cvt_pk_bf16(o[2], o[3]);
            *(u32x2*)(out + (size_t)r * DM + col) = w;
        }
    }
#undef NM_LOAD
}

struct RsRow { u32x2 y[8]; f32x4 h[8]; u32x2 hb[8]; };
template <bool HIN_F32>
__device__ __forceinline__ void rs_load(RsRow& R, int rr, int lane, const bf16_t* __restrict__ y, const bf16_t* __restrict__ ypart,
                                        const float* __restrict__ xin, const float* __restrict__ cin, const bf16_t* __restrict__ h) {
    if (HIN_F32) {
        const float* src = rr < RL ? xin + (size_t)rr * DM : cin + (size_t)(rr - RL) * DM;
#pragma unroll
        for (int j = 0; j < 8; ++j) R.h[j] = __builtin_nontemporal_load((const f32x4*)(src + j * 256 + lane * 4));
    } else {
#pragma unroll
        for (int j = 0; j < 8; ++j) R.hb[j] = __builtin_nontemporal_load((const u32x2*)(h + (size_t)rr * DM + j * 256 + lane * 4));
    }
    if (ypart != nullptr && rr >= RL) {
#pragma unroll
        for (int j = 0; j < 8; ++j) {
            const bf16_t* pp = ypart + (size_t)(rr - RL) * DM + j * 256 + lane * 4; f32x4 a = {0.f, 0.f, 0.f, 0.f};
#pragma unroll
            for (int q = 0; q < 8; ++q) { const u32x2 pv = *(const u32x2*)(pp + (size_t)q * (NB * CTX) * DM); a[0] += bflo(pv.x); a[1] += bfhi(pv.x); a[2] += bflo(pv.y); a[3] += bfhi(pv.y); }
            R.y[j].x = cvt_pk_bf16(a[0], a[1]); R.y[j].y = cvt_pk_bf16(a[2], a[3]);
        }
    } else {
#pragma unroll
        for (int j = 0; j < 8; ++j) R.y[j] = __builtin_nontemporal_load((const u32x2*)(y + (size_t)rr * DM + j * 256 + lane * 4));
    }
}
template <bool HIN_F32, bool HOUT_F32>
__device__ __forceinline__ void rs_consume(const RsRow& R, int r, int lane, const LAS float* P, void* __restrict__ hdst, bool do_norm, bf16_t* __restrict__ uout) {
    const int b = r < RL ? (r >> 12) : 4;
    const LAS float* gt = P + (2 + 3 * b) * DM;
    f32x4 v[8]; float ss = 0.f;
#pragma unroll
    for (int j = 0; j < 8; ++j) {
        v[j][0] = bflo(R.y[j].x); v[j][1] = bfhi(R.y[j].x); v[j][2] = bflo(R.y[j].y); v[j][3] = bfhi(R.y[j].y);
        ss += v[j][0] * v[j][0] + v[j][1] * v[j][1] + v[j][2] * v[j][2] + v[j][3] * v[j][3];
    }
    ss = wave_sum(ss);
    const float rstd = rsqrtf(ss * (1.0f / DM) + RMS_EPS);
    float ss2 = 0.f;
#pragma unroll
    for (int j = 0; j < 8; ++j) {
        const int col = j * 256 + lane * 4;
        const f32x4 gg = *(const LAS f32x4*)(P + col), ga = *(const LAS f32x4*)(gt + col);
        f32x4 hv;
        if (HIN_F32) hv = R.h[j];
        else { hv[0] = bflo(R.hb[j].x); hv[1] = bfhi(R.hb[j].x); hv[2] = bflo(R.hb[j].y); hv[3] = bfhi(R.hb[j].y); }
        f32x4 o;
#pragma unroll
        for (int e = 0; e < 4; ++e) { o[e] = hv[e] + ga[e] * (v[j][e] * rstd * gg[e]); ss2 += o[e] * o[e]; }
        if (HOUT_F32) __builtin_nontemporal_store(o, (f32x4*)((float*)hdst + (size_t)r * DM + col));
        else { u32x2 w; w.x = cvt_pk_bf16(o[0], o[1]); w.y = cvt_pk_bf16(o[2], o[3]); __builtin_nontemporal_store(w, (u32x2*)((bf16_t*)hdst + (size_t)r * DM + col)); }
        v[j] = o;
    }
    if (do_norm) {
        ss2 = wave_sum(ss2);
        const float rstd2 = rsqrtf(ss2 * (1.0f / DM) + RMS_EPS);
#pragma unroll
        for (int j = 0; j < 8; ++j) {
            const int col = j * 256 + lane * 4;
            const f32x4 gg = *(const LAS f32x4*)(P + DM + col), s1 = *(const LAS f32x4*)(gt + DM + col), s2 = *(const LAS f32x4*)(gt + 2 * DM + col);
            f32x4 o;
#pragma unroll
            for (int e = 0; e < 4; ++e) o[e] = (v[j][e] * rstd2 * gg[e]) * (1.f + s2[e]) + s1[e];
            u32x2 w; w.x = cvt_pk_bf16(o[0], o[1]); w.y = cvt_pk_bf16(o[2], o[3]);
            *(u32x2*)(uout + (size_t)r * DM + col) = w;
        }
    }
}
template <bool HIN_F32, bool HOUT_F32>
__device__ __forceinline__ void ph_resid(LAS unsigned char* lds, const bf16_t* __restrict__ y, const bf16_t* __restrict__ ypart, const float* __restrict__ gy, const float* __restrict__ mods, int kgate,
                                         const float* __restrict__ xin, const float* __restrict__ cin, const bf16_t* __restrict__ h,
                                         void* __restrict__ hdst, bool do_norm, const float* __restrict__ g2, const float* __restrict__ mods2, int kshift, int kscale,
                                         bf16_t* __restrict__ uout, int nrows) {
    const int lane = threadIdx.x & 63, gw = blockIdx.x * NWAVES + (threadIdx.x >> 6), nw = gridDim.x * NWAVES;
    LAS float* P = (LAS float*)lds;
    RsRow A, B;
    if (gw < nrows) rs_load<HIN_F32>(A, gw, lane, y, ypart, xin, cin, h);
    if (gw + nw < nrows) rs_load<HIN_F32>(B, gw + nw, lane, y, ypart, xin, cin, h);
    __syncthreads();
    for (int i = threadIdx.x; i < 17 * (DM / 4); i += NTHREADS) {
        const int vsel = i / (DM / 4), c4 = (i % (DM / 4)) * 4;
        f32x4 val = {0.f, 0.f, 0.f, 0.f};
        if (vsel == 0) val = *(const f32x4*)(gy + c4);
        else if (vsel == 1) { if (do_norm) val = *(const f32x4*)(g2 + c4); }
        else { const int bb = (vsel - 2) / 3, kk = (vsel - 2) % 3;
               if (kk == 0) val = *(const f32x4*)(mods + (size_t)bb * NMOD + kgate * DM + c4);
               else if (do_norm) val = *(const f32x4*)(mods2 + (size_t)bb * NMOD + (kk == 1 ? kshift : kscale) * DM + c4); }
        *(LAS f32x4*)(P + vsel * DM + c4) = val;
    }
    __syncthreads();
#pragma unroll 1
    for (int r = gw; r < nrows; r += 2 * nw) {
        rs_consume<HIN_F32, HOUT_F32>(A, r, lane, P, hdst, do_norm, uout);
        if (r + 2 * nw < nrows) rs_load<HIN_F32>(A, r + 2 * nw, lane, y, ypart, xin, cin, h);
        if (r + nw < nrows) {
            rs_consume<HIN_F32, HOUT_F32>(B, r + nw, lane, P, hdst, do_norm, uout);
            if (r + 3 * nw < nrows) rs_load<HIN_F32>(B, r + 3 * nw, lane, y, ypart, xin, cin, h);
        }
    }
}

__device__ __forceinline__ void ph_mla_rows(const bf16_t* __restrict__ z, const float* __restrict__ qg, const float* __restrict__ kvg, const f32x2* __restrict__ ropeC,
                                            bf16_t* __restrict__ zq, bf16_t* __restrict__ zkv, bf16_t* __restrict__ kr) {
    const int lane = threadIdx.x & 63, gw = blockIdx.x * NWAVES + (threadIdx.x >> 6), nw = gridDim.x * NWAVES;
    u32x2 zn[4]; bf16_t xn = 0;
#define MR_LOAD(r_) do { const bf16_t* zr_ = z + (size_t)(r_) * 1280; \
        _Pragma("unroll") for (int q_ = 0; q_ < 4; ++q_) zn[q_] = __builtin_nontemporal_load((const u32x2*)(zr_ + q_ * 256 + lane * 4)); xn = zr_[1024 + lane]; } while (0)
    if (gw < RA) MR_LOAD(gw);
    for (int r = gw; r < RA; r += nw) {
        f32x4 zc[4];
#pragma unroll
        for (int q = 0; q < 4; ++q) { zc[q][0] = bflo(zn[q].x); zc[q][1] = bfhi(zn[q].x); zc[q][2] = bflo(zn[q].y); zc[q][3] = bfhi(zn[q].y); }
        const float x = bf2f(xn);
        if (r + nw < RA) MR_LOAD(r + nw);
#pragma unroll
        for (int part = 0; part < 2; ++part) {
            const f32x4 a = zc[2 * part], b = zc[2 * part + 1];
            float ss = a[0] * a[0] + a[1] * a[1] + a[2] * a[2] + a[3] * a[3] + b[0] * b[0] + b[1] * b[1] + b[2] * b[2] + b[3] * b[3];
            ss = wave_sum(ss);
            const float rstd = rsqrtf(ss * (1.0f / 512.0f) + RMS_EPS);
            const float* gp = (part ? kvg : qg) + lane * 4;
            const f32x4 g0 = *(const f32x4*)gp, g1 = *(const f32x4*)(gp + 256);
            u32x2 w0, w1;
            w0.x = cvt_pk_bf16(a[0] * rstd * g0[0], a[1] * rstd * g0[1]); w0.y = cvt_pk_bf16(a[2] * rstd * g0[2], a[3] * rstd * g0[3]);
            w1.x = cvt_pk_bf16(b[0] * rstd * g1[0], b[1] * rstd * g1[1]); w1.y = cvt_pk_bf16(b[2] * rstd * g1[2], b[3] * rstd * g1[3]);
            bf16_t* op = (part ? zkv : zq) + (size_t)r * 512 + lane * 4;
            *(u32x2*)op = w0; *(u32x2*)(op + 256) = w1;
        }
        const float xp = __shfl_xor(x, 1);
        float o = x;
        if (r < RL) {
            const f32x2 cs = ropeC[(size_t)(r & 4095) * 32 + (lane >> 1)];
            o = (lane & 1) ? (x * cs.x + xp * cs.y) : (x * cs.x - xp * cs.y);
        }
        kr[(size_t)r * 64 + lane] = f2bf(o);
    }
#undef MR_LOAD
}

__device__ __forceinline__ void ph_headnorm(const bf16_t* __restrict__ hf, const bf16_t* __restrict__ hb, const bf16_t* __restrict__ z1, const float* __restrict__ head_g, bf16_t* __restrict__ out) {
    const int lane = threadIdx.x & 63, gw = blockIdx.x * NWAVES + (threadIdx.x >> 6), nw = gridDim.x * NWAVES;
    u32x4 an[4], bn[4], gn[4];
#define HN_LOAD(r_) do { const size_t ro_ = (size_t)(r_) * DM + lane * 8, rz_ = (size_t)(r_) * 6400 + 4096 + lane * 8; \
        _Pragma("unroll") for (int q_ = 0; q_ < 4; ++q_) { an[q_] = __builtin_nontemporal_load((const u32x4*)(hf + ro_ + q_ * 512)); bn[q_] = __builtin_nontemporal_load((const u32x4*)(hb + ro_ + q_ * 512)); \
            gn[q_] = __builtin_nontemporal_load((const u32x4*)(z1 + rz_ + q_ * 512)); } } while (0)
    if (gw < RA) HN_LOAD(gw);
    for (int r = gw; r < RA; r += nw) {
        float v[32]; float ss[4]; u32x4 og[4];
#pragma unroll
        for (int q = 0; q < 4; ++q) {
            const u32x4 a = an[q], b = bn[q]; og[q] = gn[q]; float t = 0.f;
#pragma unroll
            for (int e = 0; e < 4; ++e) { const float x0 = bflo(a[e]) + bflo(b[e]), x1 = bfhi(a[e]) + bfhi(b[e]); v[q * 8 + 2 * e] = x0; v[q * 8 + 2 * e + 1] = x1; t += x0 * x0 + x1 * x1; }
            ss[q] = t;
        }
        if (r + nw < RA) HN_LOAD(r + nw);
#pragma unroll
        for (int q = 0; q < 4; ++q) {
            float t = ss[q];
            t += __shfl_xor(t, 1); t += __shfl_xor(t, 2); t += __shfl_xor(t, 4); t += __shfl_xor(t, 8); t += __shfl_xor(t, 16);
            const float rstd = rsqrtf(t * (1.0f / 256.0f) + RMS_EPS);
            const f32x4 g0 = *(const f32x4*)(head_g + q * 512 + lane * 8), g1 = *(const f32x4*)(head_g + q * 512 + lane * 8 + 4);
            float o[8];
#pragma unroll
            for (int e = 0; e < 4; ++e) {
                const float ga = 1.f / (1.f + __expf(-bflo(og[q][e]))), gb = 1.f / (1.f + __expf(-bfhi(og[q][e])));
                const float gg0 = (e < 2) ? g0[2 * e] : g1[2 * e - 4], gg1 = (e < 2) ? g0[2 * e + 1] : g1[2 * e - 3];
                o[2 * e] = v[q * 8 + 2 * e] * rstd * gg0 * ga; o[2 * e + 1] = v[q * 8 + 2 * e + 1] * rstd * gg1 * gb;
            }
            u32x4 w; w.x = cvt_pk_bf16(o[0], o[1]); w.y = cvt_pk_bf16(o[2], o[3]); w.z = cvt_pk_bf16(o[4], o[5]); w.w = cvt_pk_bf16(o[6], o[7]);
            *(u32x4*)(out + (size_t)r * DM + q * 512 + lane * 8) = w;
        }
    }
#undef HN_LOAD
}

__device__ __forceinline__ void ph_transpose(LAS unsigned char* lds, const bf16_t* __restrict__ src, bf16_t* __restrict__ dst) {
    LAS bf16_t* tile = (LAS bf16_t*)lds;
    const int tid = threadIdx.x;
    const int ntile = (DM / 64) * (RL / 64);
    const int c = tid >> 3, ch = tid & 7;
    u32x4 wn = {0u, 0u, 0u, 0u};
    int t = blockIdx.x;
    if (t < ntile) { const int tc = t % (DM / 64), tr = t / (DM / 64); wn = __builtin_nontemporal_load((const u32x4*)(src + (size_t)(tc * 64 + c) * RL + tr * 64 + ch * 8)); }
    for (; t < ntile; t += gridDim.x) {
        const int tc = t % (DM / 64), tr = t / (DM / 64);
        *(LAS u32x4*)(tile + c * 72 + ch * 8) = wn;
        __syncthreads();
        const int t2 = t + gridDim.x;
        if (t2 < ntile) { const int tc2 = t2 % (DM / 64), tr2 = t2 / (DM / 64); wn = __builtin_nontemporal_load((const u32x4*)(src + (size_t)(tc2 * 64 + c) * RL + tr2 * 64 + ch * 8)); }
        {
            bf16_t e[8];
#pragma unroll
            for (int q = 0; q < 8; ++q) e[q] = tile[(ch * 8 + q) * 72 + c];
            u32x4 w; w.x = e[0] | ((unsigned)e[1] << 16); w.y = e[2] | ((unsigned)e[3] << 16); w.z = e[4] | ((unsigned)e[5] << 16); w.w = e[6] | ((unsigned)e[7] << 16);
            *(u32x4*)(dst + (size_t)(tr * 64 + c) * DM + tc * 64 + ch * 8) = w;
        }
        __syncthreads();
    }
}

template <int OFF> __device__ __forceinline__ s16x4 tr_read(unsigned addr) {
    s16x4 r; asm volatile("ds_read_b64_tr_b16 %0, %1 offset:%2" : "=&v"(r) : "v"(addr), "i"(OFF) : "memory"); return r;
}
#define MFMA32(a, b, c) __builtin_amdgcn_mfma_f32_32x32x16_bf16((a), (b), (c), 0, 0, 0)
#define PK8(L, H) ((bf16x8){L[0], L[1], L[2], L[3], H[0], H[1], H[2], H[3]})

constexpr int VSTR = 320;
template <int DQK> struct AttnGeo {
    static constexpr int KSTR = DQK * 2 + 16;
    static constexpr int KBUF = 64 * KSTR, VBUF = 64 * VSTR;
    static constexpr int VOFF = 2 * KBUF, TOTAL = 2 * KBUF + 2 * VBUF;
    static constexpr int KCH = DQK / 8;
    static constexpr int NKL = (64 * KCH) / NTHREADS;
};

template <int C> __device__ __forceinline__ void pv_block(f32x16& oc, unsigned vaddr, const bf16x8 (&pf)[4]) {
    const s16x4 l0 = tr_read<(0 * 16 + 0) * VSTR + C * 64>(vaddr), h0 = tr_read<(0 * 16 + 8) * VSTR + C * 64>(vaddr);
    const s16x4 l1 = tr_read<(1 * 16 + 0) * VSTR + C * 64>(vaddr), h1 = tr_read<(1 * 16 + 8) * VSTR + C * 64>(vaddr);
    const s16x4 l2 = tr_read<(2 * 16 + 0) * VSTR + C * 64>(vaddr), h2 = tr_read<(2 * 16 + 8) * VSTR + C * 64>(vaddr);
    const s16x4 l3 = tr_read<(3 * 16 + 0) * VSTR + C * 64>(vaddr), h3 = tr_read<(3 * 16 + 8) * VSTR + C * 64>(vaddr);
    asm volatile("s_waitcnt lgkmcnt(0)" ::: "memory"); __builtin_amdgcn_sched_barrier(0);
    oc = MFMA32(PK8(l0, h0), pf[0], oc);
    oc = MFMA32(PK8(l1, h1), pf[1], oc);
    oc = MFMA32(PK8(l2, h2), pf[2], oc);
    oc = MFMA32(PK8(l3, h3), pf[3], oc);
}

template <int C0, int C1> __device__ __forceinline__ void pv_block2(f32x16& oa, f32x16& ob, unsigned vaddr, const bf16x8 (&pf)[4]) {
    const s16x4 al0 = tr_read<(0 * 16 + 0) * VSTR + C0 * 64>(vaddr), ah0 = tr_read<(0 * 16 + 8) * VSTR + C0 * 64>(vaddr);
    const s16x4 bl0 = tr_read<(0 * 16 + 0) * VSTR + C1 * 64>(vaddr), bh0 = tr_read<(0 * 16 + 8) * VSTR + C1 * 64>(vaddr);
    const s16x4 al1 = tr_read<(1 * 16 + 0) * VSTR + C0 * 64>(vaddr), ah1 = tr_read<(1 * 16 + 8) * VSTR + C0 * 64>(vaddr);
    const s16x4 bl1 = tr_read<(1 * 16 + 0) * VSTR + C1 * 64>(vaddr), bh1 = tr_read<(1 * 16 + 8) * VSTR + C1 * 64>(vaddr);
    const s16x4 al2 = tr_read<(2 * 16 + 0) * VSTR + C0 * 64>(vaddr), ah2 = tr_read<(2 * 16 + 8) * VSTR + C0 * 64>(vaddr);
    const s16x4 bl2 = tr_read<(2 * 16 + 0) * VSTR + C1 * 64>(vaddr), bh2 = tr_read<(2 * 16 + 8) * VSTR + C1 * 64>(vaddr);
    const s16x4 al3 = tr_read<(3 * 16 + 0) * VSTR + C0 * 64>(vaddr), ah3 = tr_read<(3 * 16 + 8) * VSTR + C0 * 64>(vaddr);
    const s16x4 bl3 = tr_read<(3 * 16 + 0) * VSTR + C1 * 64>(vaddr), bh3 = tr_read<(3 * 16 + 8) * VSTR + C1 * 64>(vaddr);
    asm volatile("s_waitcnt lgkmcnt(0)" ::: "memory"); __builtin_amdgcn_sched_barrier(0);
    oa = MFMA32(PK8(al0, ah0), pf[0], oa); ob = MFMA32(PK8(bl0, bh0), pf[0], ob);
    oa = MFMA32(PK8(al1, ah1), pf[1], oa); ob = MFMA32(PK8(bl1, bh1), pf[1], ob);
    oa = MFMA32(PK8(al2, ah2), pf[2], oa); ob = MFMA32(PK8(bl2, bh2), pf[2], ob);
    oa = MFMA32(PK8(al3, ah3), pf[3], oa); ob = MFMA32(PK8(bl3, bh3), pf[3], ob);
}

__device__ __forceinline__ void store_tile_32x128(LAS unsigned char* stage, const f32x16 (&o)[4], float inv, bf16_t* __restrict__ orow0, int opitch, int lane) {
    const int r32 = lane & 31, hi = lane >> 5;
    LAS unsigned char* wr = stage + r32 * 272 + hi * 8;
#pragma unroll
    for (int c = 0; c < 4; ++c)
#pragma unroll
        for (int g = 0; g < 4; ++g) {
            u32x2 w; w.x = cvt_pk_bf16(o[c][4 * g] * inv, o[c][4 * g + 1] * inv); w.y = cvt_pk_bf16(o[c][4 * g + 2] * inv, o[c][4 * g + 3] * inv);
            *(LAS u32x2*)(wr + c * 64 + g * 16) = w;
        }
    __builtin_amdgcn_sched_barrier(0);
#pragma unroll 2
    for (int i = 0; i < 8; ++i) {
        const int id = lane + 64 * i, rr = id >> 4, cc = id & 15;
        const u32x4 v = *(const LAS u32x4*)(stage + rr * 272 + cc * 16);
        *(u32x4*)(orow0 + (size_t)rr * opitch + cc * 8) = v;
    }
}

template <int DQK>
__device__ __forceinline__ void attn_unit(LAS unsigned char* lds, const bf16_t* __restrict__ qp, int qpitch,
                                          const bf16_t* __restrict__ kb, int kpitch, const bf16_t* __restrict__ krb, const bf16_t* __restrict__ vb, int vpitch,
                                          int row0, int nt0, int row1, int nt1, bool masked, int kpos0, int qpos0,
                                          float sc_l2, bool has_sink, float sink_l2, bf16_t* __restrict__ op, int opitch, bool gqa = false, const float* __restrict__ sink4 = nullptr) {
    typedef AttnGeo<DQK> G;
    const int tid = threadIdx.x, wave = tid >> 6, lane = tid & 63, r32 = lane & 31, hi = lane >> 5;
    const int NT = nt0 + nt1;
    const int wrow = gqa ? (wave & 1) * 32 : wave * 32, whead = gqa ? (wave >> 1) * 128 : 0;
    if (gqa) sink_l2 = sink4[wave >> 1] * 1.4426950408889634f;
    bf16x8 qf[DQK / 16];
    {
        const bf16_t* qrow = qp + (size_t)(wrow + r32) * qpitch + whead + hi * 8;
#pragma unroll
        for (int j = 0; j < DQK / 16; ++j) qf[j] = *(const bf16x8*)(qrow + j * 16);
    }
    u32x4 kreg[G::NKL], vreg[2];
    auto tile_row = [&](int t) -> int { return t < nt0 ? row0 + 64 * t : row1 + 64 * (t - nt0); };
#define ATT_LOAD(t) do { const int rb_ = tile_row(t); \
        _Pragma("unroll") for (int i_ = 0; i_ < G::NKL; ++i_) { const int id_ = tid + i_ * NTHREADS, rr_ = id_ / G::KCH, cc_ = id_ % G::KCH; \
            kreg[i_] = (cc_ < 16) ? *(const u32x4*)(kb + (size_t)(rb_ + rr_) * kpitch + cc_ * 8) : *(const u32x4*)(krb + (size_t)(rb_ + rr_) * 64 + (cc_ - 16) * 8); } \
        _Pragma("unroll") for (int i_ = 0; i_ < 2; ++i_) { const int id_ = tid + i_ * NTHREADS, rr_ = id_ >> 4, cc_ = id_ & 15; \
            vreg[i_] = *(const u32x4*)(vb + (size_t)(rb_ + rr_) * vpitch + cc_ * 8); } } while (0)
#define ATT_WRITE(buf) do { \
        _Pragma("unroll") for (int i_ = 0; i_ < G::NKL; ++i_) { const int id_ = tid + i_ * NTHREADS, rr_ = id_ / G::KCH, cc_ = id_ % G::KCH; \
            *(LAS u32x4*)(lds + (buf) * G::KBUF + rr_ * G::KSTR + cc_ * 16) = kreg[i_]; } \
        _Pragma("unroll") for (int i_ = 0; i_ < 2; ++i_) { const int id_ = tid + i_ * NTHREADS, rr_ = id_ >> 4, cc_ = id_ & 15; \
            *(LAS u32x4*)(lds + G::VOFF + (buf) * G::VBUF + rr_ * VSTR + cc_ * 16) = vreg[i_]; } } while (0)

    float m = has_sink ? sink_l2 : -1e30f;
    float l = (has_sink && hi == 0) ? 1.f : 0.f;
    f32x16 o[4];
#pragma unroll
    for (int c = 0; c < 4; ++c)
#pragma unroll
        for (int r = 0; r < 16; ++r) o[c][r] = 0.f;
    const int qpos = qpos0 + wrow + r32;
    const unsigned vlane = (unsigned)(size_t)(lds + G::VOFF) + (unsigned)((4 * hi + ((lane & 15) >> 2)) * VSTR + ((lane >> 4) & 1) * 32 + (lane & 3) * 8);

    __syncthreads();
    ATT_LOAD(0); ATT_WRITE(0);
    __syncthreads();
    for (int t = 0; t < NT; ++t) {
        const int buf = t & 1;
        if (t + 1 < NT) ATT_LOAD(t + 1);
        const int kt0_ = kpos0 + 64 * t, ql_ = qpos0 + wrow;
        const bool live = !(masked && t < nt0) || ((kt0_ + 63 >= ql_ - 128) && (kt0_ <= ql_ + 31 + 128));
        if (live) {
        f32x16 s0, s1;
#pragma unroll
        for (int r = 0; r < 16; ++r) { s0[r] = 0.f; s1[r] = 0.f; }
        {
            const LAS unsigned char* kbuf = lds + buf * G::KBUF + r32 * G::KSTR + hi * 16;
#pragma unroll
            for (int j = 0; j < DQK / 16; ++j) {
                const bf16x8 a0 = *(const LAS bf16x8*)(kbuf + j * 32);
                const bf16x8 a1 = *(const LAS bf16x8*)(kbuf + 32 * G::KSTR + j * 32);
                s0 = MFMA32(a0, qf[j], s0);
                s1 = MFMA32(a1, qf[j], s1);
            }
        }
        const bool mt = masked && (t < nt0);
        const int kp0 = kpos0 + 64 * t - qpos;
        float mx = -1e30f;
#pragma unroll
        for (int r = 0; r < 16; ++r) {
            float x0 = s0[r], x1 = s1[r];
            if (mt) { const int d0 = kp0 + crow(r, hi), d1 = d0 + 32; if (d0 > 128 || d0 < -128) x0 = -1e30f; if (d1 > 128 || d1 < -128) x1 = -1e30f; }
            s0[r] = x0; s1[r] = x1; mx = fmaxf(mx, fmaxf(x0, x1));
        }
        mx = fmaxf(mx, __shfl_xor(mx, 32));
        const float mn = fmaxf(m, mx * sc_l2);
        const float alpha = __builtin_amdgcn_exp2f(m - mn);
        m = mn;
        float ps = 0.f;
#pragma unroll
        for (int r = 0; r < 16; ++r) { const float p0 = __builtin_amdgcn_exp2f(__builtin_fmaf(s0[r], sc_l2, -mn)), p1 = __builtin_amdgcn_exp2f(__builtin_fmaf(s1[r], sc_l2, -mn)); s0[r] = p0; s1[r] = p1; ps += p0 + p1; }
        l = l * alpha + ps;
        if (DQK != 192 || __any(alpha < 1.f)) {
#pragma unroll
            for (int c = 0; c < 4; ++c)
#pragma unroll
                for (int r = 0; r < 16; ++r) o[c][r] *= alpha;
        }
        bf16x8 pf[4];
        {
            u32x4 w;
            w.x = cvt_pk_bf16(s0[0], s0[1]); w.y = cvt_pk_bf16(s0[2], s0[3]); w.z = cvt_pk_bf16(s0[4], s0[5]); w.w = cvt_pk_bf16(s0[6], s0[7]); pf[0] = *(bf16x8*)&w;
            w.x = cvt_pk_bf16(s0[8], s0[9]); w.y = cvt_pk_bf16(s0[10], s0[11]); w.z = cvt_pk_bf16(s0[12], s0[13]); w.w = cvt_pk_bf16(s0[14], s0[15]); pf[1] = *(bf16x8*)&w;
            w.x = cvt_pk_bf16(s1[0], s1[1]); w.y = cvt_pk_bf16(s1[2], s1[3]); w.z = cvt_pk_bf16(s1[4], s1[5]); w.w = cvt_pk_bf16(s1[6], s1[7]); pf[2] = *(bf16x8*)&w;
            w.x = cvt_pk_bf16(s1[8], s1[9]); w.y = cvt_pk_bf16(s1[10], s1[11]); w.z = cvt_pk_bf16(s1[12], s1[13]); w.w = cvt_pk_bf16(s1[14], s1[15]); pf[3] = *(bf16x8*)&w;
        }
        {
            const unsigned va = vlane + (unsigned)(buf * G::VBUF);
            pv_block2<0, 1>(o[0], o[1], va, pf); pv_block2<2, 3>(o[2], o[3], va, pf);
        }
        }
        if (t + 1 < NT) ATT_WRITE(buf ^ 1);
        __syncthreads();
    }
    l += __shfl_xor(l, 32);
    const float inv = 1.f / l;
    store_tile_32x128(lds + wave * (32 * 272), o, inv, op + (size_t)wrow * opitch + whead, opitch, lane);
#undef ATT_LOAD
#undef ATT_WRITE
}

constexpr int ML_KWSTR = 320;
constexpr int ML_VSTR  = 576;
constexpr int ML_CSTR  = 272;

__device__ __forceinline__ int ml_rowbase(int b, int c) { return c == 0 ? RL + b * CTX : b * SEQ + (c - 1) * 256; }

__device__ __forceinline__ float ml_gates(LAS float* bt, LAS float* ip, LAS float* sbuf, const bf16_t* __restrict__ z1, const float* __restrict__ gate_b, int rbase, int h, int dir) {
    const int tid = threadIdx.x;
    const int j = dir ? 255 - tid : tid;
    if (tid < 256) {
        const bf16_t* zr = z1 + (size_t)(rbase + tid) * 6400 + 6144 + dir * 8 + h;
        const float gi = bf2f(zr[0]) + gate_b[dir * 8 + h];
        const float gf = bf2f(zr[16]) + gate_b[16 + dir * 8 + h];
        const float lf = fminf(gf, 0.f) - log1pf(__expf(-fabsf(gf)));
        ip[tid] = gi; sbuf[j] = lf;
    }
    __syncthreads();
    for (int off = 1; off < 256; off <<= 1) {
        float v = 0.f;
        if (tid < 256 && tid >= off) v = sbuf[tid - off];
        __syncthreads();
        if (tid < 256) sbuf[tid] += v;
        __syncthreads();
    }
    if (tid < 256) bt[tid] = sbuf[j];
    const float bend = sbuf[255];
    __syncthreads();
    return bend;
}

__device__ __forceinline__ void ph_ml_p1(LAS unsigned char* lds, const bf16_t* __restrict__ z1, const float* __restrict__ gate_b, bf16_t* __restrict__ DC, float* __restrict__ DN, float* __restrict__ AC, float* __restrict__ GB, int lid) {
    const int tid = threadIdx.x, wave = tid >> 6, lane = tid & 63, r32 = lane & 31, hi = lane >> 5;
    LAS float* bt = (LAS float*)lds; LAS float* ip = bt + 256; LAS float* sbuf = ip + 256; LAS float* wv = sbuf + 256;
    constexpr int P1BUF = 64 * ML_KWSTR + 64 * ML_VSTR;
    LAS unsigned char* tb = lds + 4096;
    const unsigned lane_off = (unsigned)((4 * hi + ((lane & 15) >> 2))) ;
    const unsigned kaddr0 = (unsigned)(size_t)tb + lane_off * ML_KWSTR + ((lane >> 4) & 1) * 32 + (lane & 3) * 8;
    const unsigned vaddr0 = (unsigned)(size_t)(tb + 64 * ML_KWSTR) + lane_off * ML_VSTR + ((lane >> 4) & 1) * 32 + (lane & 3) * 8 + wave * 64;
    for (int item = lid; item < 1088; item += gridDim.x) {
        const int c = item % 17, seq = item / 17, dir = seq & 1, h = (seq >> 1) & 7, b = seq >> 4;
        const int rbase = ml_rowbase(b, c);
        u32x4 kreg[2], vreg[4];
#define P1_LOAD(st_) do { \
            _Pragma("unroll") for (int i_ = 0; i_ < 2; ++i_) { const int id_ = tid + i_ * NTHREADS, rr_ = id_ >> 4, cc_ = id_ & 15; \
                kreg[i_] = *(const u32x4*)(z1 + (size_t)(rbase + (st_) * 64 + rr_) * 6400 + 1024 + h * 128 + cc_ * 8); } \
            _Pragma("unroll") for (int i_ = 0; i_ < 4; ++i_) { const int id_ = tid + i_ * NTHREADS, rr_ = id_ >> 5, cc_ = id_ & 31; \
                vreg[i_] = *(const u32x4*)(z1 + (size_t)(rbase + (st_) * 64 + rr_) * 6400 + 2048 + h * 256 + cc_ * 8); } } while (0)
#define P1_WRITE(st_, buf_) do { LAS unsigned char* kw_ = tb + (buf_) * P1BUF; LAS unsigned char* vt_ = kw_ + 64 * ML_KWSTR; \
            _Pragma("unroll") for (int i_ = 0; i_ < 2; ++i_) { const int id_ = tid + i_ * NTHREADS, rr_ = id_ >> 4, cc_ = id_ & 15; \
                const u32x4 kx_ = kreg[i_]; const float w_ = wv[(st_) * 64 + rr_]; u32x4 o_; \
                o_.x = cvt_pk_bf16(bflo(kx_.x) * w_, bfhi(kx_.x) * w_); o_.y = cvt_pk_bf16(bflo(kx_.y) * w_, bfhi(kx_.y) * w_); \
                o_.z = cvt_pk_bf16(bflo(kx_.z) * w_, bfhi(kx_.z) * w_); o_.w = cvt_pk_bf16(bflo(kx_.w) * w_, bfhi(kx_.w) * w_); \
                *(LAS u32x4*)(kw_ + rr_ * ML_KWSTR + cc_ * 16) = o_; } \
            _Pragma("unroll") for (int i_ = 0; i_ < 4; ++i_) { const int id_ = tid + i_ * NTHREADS, rr_ = id_ >> 5, cc_ = id_ & 31; \
                *(LAS u32x4*)(vt_ + rr_ * ML_VSTR + cc_ * 16) = vreg[i_]; } } while (0)
        P1_LOAD(0);
        const float bend = ml_gates(bt, ip, sbuf, z1, gate_b, rbase, h, dir);
        if (tid < 256) {
            wv[tid] = __expf(bend - bt[tid] + ip[tid]);
            GB[(size_t)item * 512 + tid] = bt[tid]; GB[(size_t)item * 512 + 256 + tid] = ip[tid];
        }
        __syncthreads();
        P1_WRITE(0, 0);
        __syncthreads();
        f32x16 acc[4];
#pragma unroll
        for (int dt = 0; dt < 4; ++dt)
#pragma unroll
            for (int r = 0; r < 16; ++r) acc[dt][r] = 0.f;
        float dn = 0.f;
#pragma unroll 1
        for (int st = 0; st < 4; ++st) {
            const int buf = st & 1;
            if (st + 1 < 4) P1_LOAD(st + 1);
            const LAS unsigned char* kw = tb + buf * P1BUF;
            {
                const LAS unsigned char* kc = kw + (tid >> 7) * 16 * ML_KWSTR + (tid & 127) * 2;
#pragma unroll
                for (int s_ = 0; s_ < 16; ++s_) dn += bf2f(*(const LAS bf16_t*)(kc + s_ * ML_KWSTR));
            }
            const unsigned kaddr = kaddr0 + (unsigned)(buf * P1BUF), vaddr = vaddr0 + (unsigned)(buf * P1BUF);
#define ML_P1_STEP(KS) do { \
                const s16x4 al = tr_read<(KS * 16 + 0) * ML_VSTR>(vaddr), ah = tr_read<(KS * 16 + 8) * ML_VSTR>(vaddr); \
                const s16x4 b0l = tr_read<(KS * 16 + 0) * ML_KWSTR + 0>(kaddr), b0h = tr_read<(KS * 16 + 8) * ML_KWSTR + 0>(kaddr); \
                const s16x4 b1l = tr_read<(KS * 16 + 0) * ML_KWSTR + 64>(kaddr), b1h = tr_read<(KS * 16 + 8) * ML_KWSTR + 64>(kaddr); \
                const s16x4 b2l = tr_read<(KS * 16 + 0) * ML_KWSTR + 128>(kaddr), b2h = tr_read<(KS * 16 + 8) * ML_KWSTR + 128>(kaddr); \
                const s16x4 b3l = tr_read<(KS * 16 + 0) * ML_KWSTR + 192>(kaddr), b3h = tr_read<(KS * 16 + 8) * ML_KWSTR + 192>(kaddr); \
                asm volatile("s_waitcnt lgkmcnt(0)" ::: "memory"); __builtin_amdgcn_sched_barrier(0); \
                const bf16x8 af = PK8(al, ah); \
                acc[0] = MFMA32(PK8(b0l, b0h), af, acc[0]); acc[1] = MFMA32(PK8(b1l, b1h), af, acc[1]); \
                acc[2] = MFMA32(PK8(b2l, b2h), af, acc[2]); acc[3] = MFMA32(PK8(b3l, b3h), af, acc[3]); } while (0)
            ML_P1_STEP(0); ML_P1_STEP(1); ML_P1_STEP(2); ML_P1_STEP(3);
#undef ML_P1_STEP
            if (st + 1 < 4) P1_WRITE(st + 1, buf ^ 1);
            __syncthreads();
        }
#undef P1_LOAD
#undef P1_WRITE
        store_tile_32x128(tb + wave * (32 * 272), acc, 1.0f, DC + (size_t)item * 32768 + (size_t)(32 * wave) * 128, 128, lane);
        sbuf[tid] = dn;
        __syncthreads();
        if (tid < 128) DN[(size_t)item * 128 + tid] = sbuf[tid] + sbuf[128 + tid] + sbuf[256 + tid] + sbuf[384 + tid];
        if (tid == 0) AC[item] = __expf(bend);
        __syncthreads();
    }
}

__device__ __forceinline__ void ph_ml_p2(const bf16_t* __restrict__ DC, const float* __restrict__ DN, const float* __restrict__ AC, bf16_t* __restrict__ CS, float* __restrict__ NS) {
    const int gt = blockIdx.x * NTHREADS + threadIdx.x, gn = gridDim.x * NTHREADS;
    for (int i = gt; i < 64 * 8192; i += gn) {
        const int seq = i >> 13, e4 = i & 8191, dir = seq & 1;
        f32x4 C = {0.f, 0.f, 0.f, 0.f};
        u32x2 dcr[16]; float acr[16];
#pragma unroll
        for (int j = 0; j < 16; ++j) { const int c = dir ? (j == 0 ? 0 : 17 - j) : j; const size_t item = (size_t)seq * 17 + c; dcr[j] = __builtin_nontemporal_load((const u32x2*)(DC + item * 32768 + e4 * 4)); acr[j] = AC[item]; }
#pragma unroll
        for (int j = 0; j < 17; ++j) {
            const int c = dir ? (j == 0 ? 0 : 17 - j) : j;
            const size_t item = (size_t)seq * 17 + c;
            u32x2 w; w.x = cvt_pk_bf16(C[0], C[1]); w.y = cvt_pk_bf16(C[2], C[3]);
            *(u32x2*)(CS + item * 32768 + e4 * 4) = w;
            if (j < 16) { const float a = acr[j]; const u32x2 dw = dcr[j]; f32x4 d; d[0] = bflo(dw.x); d[1] = bfhi(dw.x); d[2] = bflo(dw.y); d[3] = bfhi(dw.y); C = C * a + d; }
        }
    }
    for (int i = gt; i < 64 * 128; i += gn) {
        const int seq = i >> 7, e = i & 127, dir = seq & 1;
        float n = 0.f;
        for (int j = 0; j < 17; ++j) {
            const int c = dir ? (j == 0 ? 0 : 17 - j) : j;
            const size_t item = (size_t)seq * 17 + c;
            NS[item * 128 + e] = n;
            if (j < 16) n = n * AC[item] + DN[item * 128 + e];
        }
    }
}

__device__ __forceinline__ void ph_ml_p3(LAS unsigned char* lds, const bf16_t* __restrict__ z1, const float* __restrict__ GB, const bf16_t* __restrict__ CS, const float* __restrict__ NS, bf16_t* __restrict__ HD, int lid) {
    const int tid = threadIdx.x, wave = tid >> 6, lane = tid & 63, r32 = lane & 31, hi = lane >> 5;
    LAS float* bt = (LAS float*)lds; LAS float* ck = bt + 256; LAS float* nst = ck + 256;
    LAS unsigned char* cst = lds + 4096;
    LAS unsigned char* tb = cst + 128 * ML_CSTR;
    constexpr int P3BUF = 64 * ML_CSTR + 64 * VSTR;
    const unsigned vlane0 = (unsigned)(size_t)(tb + 64 * ML_CSTR) + (unsigned)((4 * hi + ((lane & 15) >> 2)) * VSTR + ((lane >> 4) & 1) * 32 + (lane & 3) * 8);
    for (int it = lid; it < 2176; it += gridDim.x) {
        const int vh = it & 1, item = it >> 1;
        const int c = item % 17, seq = item / 17, dir = seq & 1, h = (seq >> 1) & 7, b = seq >> 4;
        const int rbase = ml_rowbase(b, c);
        u32x4 kA[2], vA[2], kB[2], vB[2];
#define P3_LOAD(KR, VR, kt_) do { \
            _Pragma("unroll") for (int i_ = 0; i_ < 2; ++i_) { const int id_ = tid + i_ * NTHREADS, rr_ = id_ >> 4, cc_ = id_ & 15; const size_t ro_ = (size_t)(rbase + (kt_) * 64 + rr_) * 6400; \
                KR[i_] = *(const u32x4*)(z1 + ro_ + 1024 + h * 128 + cc_ * 8); VR[i_] = *(const u32x4*)(z1 + ro_ + 2048 + h * 256 + vh * 128 + cc_ * 8); } } while (0)
#define P3_WRITE(KR, VR, buf_) do { LAS unsigned char* kt_ = tb + (buf_) * P3BUF; LAS unsigned char* vt_ = kt_ + 64 * ML_CSTR; \
            _Pragma("unroll") for (int i_ = 0; i_ < 2; ++i_) { const int id_ = tid + i_ * NTHREADS, rr_ = id_ >> 4, cc_ = id_ & 15; \
                *(LAS u32x4*)(kt_ + rr_ * ML_CSTR + cc_ * 16) = KR[i_]; *(LAS u32x4*)(vt_ + rr_ * VSTR + cc_ * 16) = VR[i_]; } } while (0)
        __syncthreads();
        P3_LOAD(kA, vA, 0); P3_LOAD(kB, vB, 1);
        if (tid < 256) { const float bv = GB[(size_t)item * 512 + tid], iv = GB[(size_t)item * 512 + 256 + tid]; bt[tid] = bv; ck[tid] = iv - bv; }
        if (tid < 128) nst[tid] = NS[(size_t)item * 128 + tid];
#pragma unroll
        for (int i = 0; i < 4; ++i) {
            const int id = tid + i * NTHREADS, rr = id >> 4, cc = id & 15;
            const u32x4 x = *(const u32x4*)(CS + (size_t)item * 32768 + (size_t)(vh * 128 + rr) * 128 + cc * 8);
            *(LAS u32x4*)(cst + rr * ML_CSTR + cc * 16) = x;
        }
        const int tq = wave * 32 + r32;
        bf16x8 qf[8];
        {
            const bf16_t* qrow = z1 + (size_t)(rbase + tq) * 6400 + h * 128 + hi * 8;
#pragma unroll
            for (int j = 0; j < 8; ++j) qf[j] = *(const bf16x8*)(qrow + j * 16);
        }
        P3_WRITE(kA, vA, 0);
        __syncthreads();
        const float bq = bt[tq];
        const float g = __expf(bq);
        f32x16 o[4];
#pragma unroll
        for (int c4 = 0; c4 < 4; ++c4)
#pragma unroll
            for (int r = 0; r < 16; ++r) o[c4][r] = 0.f;
        float den = 0.f;
        {
            const LAS unsigned char* cb = cst + r32 * ML_CSTR + hi * 16;
#pragma unroll
            for (int j = 0; j < 8; ++j) {
#pragma unroll
                for (int c4 = 0; c4 < 4; ++c4) { const bf16x8 a = *(const LAS bf16x8*)(cb + c4 * 32 * ML_CSTR + j * 32); o[c4] = MFMA32(a, qf[j], o[c4]); }
                const f32x4 n0 = *(const LAS f32x4*)(nst + 16 * j + 8 * hi), n1 = *(const LAS f32x4*)(nst + 16 * j + 8 * hi + 4);
                const u32x4 qw = *(const u32x4*)&qf[j];
                den += bflo(qw.x) * n0[0] + bfhi(qw.x) * n0[1] + bflo(qw.y) * n0[2] + bfhi(qw.y) * n0[3] + bflo(qw.z) * n1[0] + bfhi(qw.z) * n1[1] + bflo(qw.w) * n1[2] + bfhi(qw.w) * n1[3];
            }
#pragma unroll
            for (int c4 = 0; c4 < 4; ++c4)
#pragma unroll
                for (int r = 0; r < 16; ++r) o[c4][r] *= g;
            den *= g;
        }
#define P3_TILE(kti, buf) do { \
            const bool rel = dir ? (64 * kti + 63 >= 32 * wave) : (64 * kti <= 32 * wave + 31); \
            if (rel) { \
                f32x16 s0, s1; \
_Pragma("unroll") \
                for (int r = 0; r < 16; ++r) { s0[r] = 0.f; s1[r] = 0.f; } \
                const LAS unsigned char* kb = tb + buf * P3BUF + r32 * ML_CSTR + hi * 16; \
_Pragma("unroll") \
                for (int j = 0; j < 8; ++j) { \
                    const bf16x8 a0 = *(const LAS bf16x8*)(kb + j * 32), a1 = *(const LAS bf16x8*)(kb + 32 * ML_CSTR + j * 32); \
                    s0 = MFMA32(a0, qf[j], s0); s1 = MFMA32(a1, qf[j], s1); \
                } \
                float ps = 0.f; \
_Pragma("unroll") \
                for (int gq = 0; gq < 4; ++gq) { \
                    const int k0 = 64 * kti + 8 * gq + 4 * hi; \
                    const f32x4 c0 = *(const LAS f32x4*)(ck + k0), c1 = *(const LAS f32x4*)(ck + k0 + 32); \
_Pragma("unroll") \
                    for (int e = 0; e < 4; ++e) { \
                        const int ts0 = k0 + e, ts1 = ts0 + 32; \
                        const bool v0 = dir ? (ts0 >= tq) : (ts0 <= tq), v1 = dir ? (ts1 >= tq) : (ts1 <= tq); \
                        const float w0 = v0 ? __expf(bq + c0[e]) : 0.f, w1 = v1 ? __expf(bq + c1[e]) : 0.f; \
                        const float p0 = s0[4 * gq + e] * w0, p1 = s1[4 * gq + e] * w1; \
                        s0[4 * gq + e] = p0; s1[4 * gq + e] = p1; ps += p0 + p1; \
                    } \
                } \
                den += ps; \
                bf16x8 pf[4]; \
                { \
                    u32x4 w; \
                    w.x = cvt_pk_bf16(s0[0], s0[1]); w.y = cvt_pk_bf16(s0[2], s0[3]); w.z = cvt_pk_bf16(s0[4], s0[5]); w.w = cvt_pk_bf16(s0[6], s0[7]); pf[0] = *(bf16x8*)&w; \
                    w.x = cvt_pk_bf16(s0[8], s0[9]); w.y = cvt_pk_bf16(s0[10], s0[11]); w.z = cvt_pk_bf16(s0[12], s0[13]); w.w = cvt_pk_bf16(s0[14], s0[15]); pf[1] = *(bf16x8*)&w; \
                    w.x = cvt_pk_bf16(s1[0], s1[1]); w.y = cvt_pk_bf16(s1[2], s1[3]); w.z = cvt_pk_bf16(s1[4], s1[5]); w.w = cvt_pk_bf16(s1[6], s1[7]); pf[2] = *(bf16x8*)&w; \
                    w.x = cvt_pk_bf16(s1[8], s1[9]); w.y = cvt_pk_bf16(s1[10], s1[11]); w.z = cvt_pk_bf16(s1[12], s1[13]); w.w = cvt_pk_bf16(s1[14], s1[15]); pf[3] = *(bf16x8*)&w; \
                } \
                const unsigned vlane = vlane0 + (unsigned)(buf * P3BUF); \
                pv_block<0>(o[0], vlane, pf); pv_block<1>(o[1], vlane, pf); pv_block<2>(o[2], vlane, pf); pv_block<3>(o[3], vlane, pf); \
            } \
        } while (0)
#pragma unroll 1
        for (int kp = 0; kp < 2; ++kp) {
            if (kp == 0) P3_LOAD(kA, vA, 2);
            P3_TILE((2 * kp), 0);
            P3_WRITE(kB, vB, 1);
            __syncthreads();
            if (kp == 0) P3_LOAD(kB, vB, 3);
            P3_TILE((2 * kp + 1), 1);
            if (kp == 0) P3_WRITE(kA, vA, 0);
            __syncthreads();
        }
#undef P3_TILE
#undef P3_LOAD
#undef P3_WRITE
        den += __shfl_xor(den, 32);
        const float inv = 1.f / fmaxf(fabsf(den), 1.f);
        store_tile_32x128(tb + wave * (32 * 272), o, inv, HD + (size_t)dir * RA * DM + (size_t)(rbase + wave * 32) * DM + h * 256 + vh * 128, DM, lane);
    }
}

#define FP(i) ((i) + 2 * ((i) >> 4))
constexpr int FFT_BUF_BYTES = (8192 + 2 * 512) * 8;
__device__ __forceinline__ f32x2 cmul(f32x2 a, f32x2 b) { f32x2 r; r.x = a.x * b.x - a.y * b.y; r.y = a.x * b.y + a.y * b.x; return r; }
__device__ __forceinline__ f32x2 cmulc(f32x2 a, f32x2 b) { f32x2 r; r.x = a.x * b.x + a.y * b.y; r.y = a.y * b.x - a.x * b.y; return r; }
__device__ __forceinline__ f32x2 mul_mi(f32x2 a) { f32x2 r; r.x = a.y; r.y = -a.x; return r; }
template <bool INV> __device__ __forceinline__ void bfly(f32x2& a, f32x2& b, f32x2 w) {
    if (!INV) { const f32x2 s = a + b, d = a - b; a = s; b = cmul(d, w); }
    else { const f32x2 t = cmulc(b, w); const f32x2 s = a + t, d = a - t; a = s; b = d; }
}
__device__ __forceinline__ void b_1(f32x2& a, f32x2& b) { const f32x2 s = a + b, d = a - b; a = s; b = d; }
__device__ __forceinline__ void f_mi(f32x2& a, f32x2& b) { const f32x2 s = a + b, d = a - b; a = s; b.x = d.y; b.y = -d.x; }
__device__ __forceinline__ void f_c1(f32x2& a, f32x2& b) { const float r = 0.70710678118654752f; const f32x2 s = a + b, d = a - b; a = s; b.x = r * (d.x + d.y); b.y = r * (d.y - d.x); }
__device__ __forceinline__ void f_c3(f32x2& a, f32x2& b) { const float r = 0.70710678118654752f; const f32x2 s = a + b, d = a - b; a = s; b.x = r * (d.y - d.x); b.y = -r * (d.x + d.y); }
__device__ __forceinline__ void i_mi(f32x2& a, f32x2& b) { f32x2 t; t.x = -b.y; t.y = b.x; const f32x2 s = a + t, d = a - t; a = s; b = d; }
__device__ __forceinline__ void i_c1(f32x2& a, f32x2& b) { const float r = 0.70710678118654752f; f32x2 t; t.x = r * (b.x - b.y); t.y = r * (b.x + b.y); const f32x2 s = a + t, d = a - t; a = s; b = d; }
__device__ __forceinline__ void i_c3(f32x2& a, f32x2& b) { const float r = 0.70710678118654752f; f32x2 t; t.x = -r * (b.x + b.y); t.y = r * (b.x - b.y); const f32x2 s = a + t, d = a - t; a = s; b = d; }
template <bool INV> __device__ __forceinline__ void radix8(f32x2 (&e)[8], const LAS f32x2* twp, int i1) {
    const f32x2 t1 = twp[i1], t2 = cmul(t1, t1), t3 = cmul(t1, t2), t4 = cmul(t2, t2), t5 = cmul(t1, t4), t6 = cmul(t2, t4), t7 = cmul(t3, t4);
    if (!INV) {
        b_1(e[0], e[4]); f_c1(e[1], e[5]); f_mi(e[2], e[6]); f_c3(e[3], e[7]);
        b_1(e[0], e[2]); f_mi(e[1], e[3]); b_1(e[4], e[6]); f_mi(e[5], e[7]);
        b_1(e[0], e[1]); b_1(e[2], e[3]); b_1(e[4], e[5]); b_1(e[6], e[7]);
        e[1] = cmul(e[1], t4); e[2] = cmul(e[2], t2); e[3] = cmul(e[3], t6); e[4] = cmul(e[4], t1); e[5] = cmul(e[5], t5); e[6] = cmul(e[6], t3); e[7] = cmul(e[7], t7);
    } else {
        e[1] = cmulc(e[1], t4); e[2] = cmulc(e[2], t2); e[3] = cmulc(e[3], t6); e[4] = cmulc(e[4], t1); e[5] = cmulc(e[5], t5); e[6] = cmulc(e[6], t3); e[7] = cmulc(e[7], t7);
        b_1(e[0], e[1]); b_1(e[2], e[3]); b_1(e[4], e[5]); b_1(e[6], e[7]);
        b_1(e[0], e[2]); i_mi(e[1], e[3]); b_1(e[4], e[6]); i_mi(e[5], e[7]);
        b_1(e[0], e[4]); i_c1(e[1], e[5]); i_mi(e[2], e[6]); i_c3(e[3], e[7]);
    }
}
template <bool INV> __device__ __forceinline__ void radix16(f32x2 (&e)[16]) {
    const float c1 = 0.92387953251128674f, s1 = 0.38268343236508977f;
    f32x2 w1, w3, w5, w7; w1.x = c1; w1.y = -s1; w3.x = s1; w3.y = -c1; w5.x = -s1; w5.y = -c1; w7.x = -c1; w7.y = -s1;
    if (!INV) {
        b_1(e[0], e[8]); bfly<false>(e[1], e[9], w1); f_c1(e[2], e[10]); bfly<false>(e[3], e[11], w3); f_mi(e[4], e[12]); bfly<false>(e[5], e[13], w5); f_c3(e[6], e[14]); bfly<false>(e[7], e[15], w7);
#pragma unroll
        for (int g = 0; g < 16; g += 8) { b_1(e[g], e[g + 4]); f_c1(e[g + 1], e[g + 5]); f_mi(e[g + 2], e[g + 6]); f_c3(e[g + 3], e[g + 7]); }
#pragma unroll
        for (int g = 0; g < 16; g += 4) { b_1(e[g], e[g + 2]); f_mi(e[g + 1], e[g + 3]); }
#pragma unroll
        for (int g = 0; g < 16; g += 2) b_1(e[g], e[g + 1]);
    } else {
#pragma unroll
        for (int g = 0; g < 16; g += 2) b_1(e[g], e[g + 1]);
#pragma unroll
        for (int g = 0; g < 16; g += 4) { b_1(e[g], e[g + 2]); i_mi(e[g + 1], e[g + 3]); }
#pragma unroll
        for (int g = 0; g < 16; g += 8) { b_1(e[g], e[g + 4]); i_c1(e[g + 1], e[g + 5]); i_mi(e[g + 2], e[g + 6]); i_c3(e[g + 3], e[g + 7]); }
        b_1(e[0], e[8]); bfly<true>(e[1], e[9], w1); i_c1(e[2], e[10]); bfly<true>(e[3], e[11], w3); i_mi(e[4], e[12]); bfly<true>(e[5], e[13], w5); i_c3(e[6], e[14]); bfly<true>(e[7], e[15], w7);
    }
}
template <bool INV, int LH, bool ZHI, bool LOH> __device__ __forceinline__ void fft_pass8_body(LAS f32x2* buf, const LAS f32x2* tw, int tid) {
    constexpr int LQ = LH - 2, Q4 = 1 << LQ, STEP = Q4 + Q4 / 8;
    asm volatile("" : "+v"(tid));
#pragma unroll
    for (int it = 0; it < 2; ++it) {
        const int j = tid + it * NTHREADS, blk = j >> LQ, pos = j & (Q4 - 1), base = (blk << (LH + 1)) + pos;
        const int i1 = pos << (12 - LH);
        LAS f32x2* pb = buf + FP(base);
        f32x2 e[8];
#pragma unroll
        for (int m = 0; m < 8; ++m) {
            if (ZHI && m >= 4) { e[m].x = 0.f; e[m].y = 0.f; }
            else e[m] = pb[m * STEP];
        }
        radix8<INV>(e, tw, i1);
#pragma unroll
        for (int m = 0; m < 8; ++m) { if (!(LOH && m >= 4)) pb[m * STEP] = e[m]; }
    }
}
template <bool INV, int LH, bool ZHI, bool LOH> __device__ __forceinline__ void fft_pass8(LAS f32x2* buf, const LAS f32x2* tw, int tid) {
    fft_pass8_body<INV, LH, ZHI, LOH>(buf, tw, tid);
    __syncthreads();
}
template <bool INV, int LH, bool ZHI, bool LOH> __device__ __forceinline__ void fft_pass8x2(LAS f32x2* A, LAS f32x2* B, const LAS f32x2* tw, int tid) {
    fft_pass8_body<INV, LH, ZHI, LOH>(A, tw, tid);
    __builtin_amdgcn_sched_barrier(0);
    fft_pass8_body<INV, LH, ZHI, LOH>(B, tw, tid);
    __syncthreads();
}
__device__ __forceinline__ void ld16(f32x2 (&e)[16], const LAS f32x2* p) {
#pragma unroll
    for (int m = 0; m < 8; ++m) { const f32x4 v = *(const LAS f32x4*)(p + 2 * m); e[2 * m].x = v[0]; e[2 * m].y = v[1]; e[2 * m + 1].x = v[2]; e[2 * m + 1].y = v[3]; }
}
__device__ __forceinline__ void st16(const f32x2 (&e)[16], LAS f32x2* p) {
#pragma unroll
    for (int m = 0; m < 8; ++m) { f32x4 v; v[0] = e[2 * m].x; v[1] = e[2 * m].y; v[2] = e[2 * m + 1].x; v[3] = e[2 * m + 1].y; *(LAS f32x4*)(p + 2 * m) = v; }
}
__device__ __forceinline__ void fft_fwd_regs(LAS f32x2* buf, const LAS f32x2* tw, f32x2 (&hreg)[16]) {
    int tid = threadIdx.x; asm volatile("" : "+v"(tid));
    fft_pass8<false, 12, false, false>(buf, tw, tid); fft_pass8<false, 9, false, false>(buf, tw, tid); fft_pass8<false, 6, false, false>(buf, tw, tid);
    ld16(hreg, buf + 18 * tid); radix16<false>(hreg);
    __syncthreads();
}
__device__ __forceinline__ void fft_conv2(LAS f32x2* XA, LAS f32x2* XB, const f32x2 (&hreg)[16], const LAS f32x2* tw) {
    int tid = threadIdx.x; asm volatile("" : "+v"(tid));
    fft_pass8x2<false, 12, true, false>(XA, XB, tw, tid); fft_pass8x2<false, 9, false, false>(XA, XB, tw, tid); fft_pass8x2<false, 6, false, false>(XA, XB, tw, tid);
#pragma unroll
    for (int hb = 0; hb < 2; ++hb) {
        f32x2 e[16]; LAS f32x2* p = (hb ? XB : XA) + 18 * tid;
        ld16(e, p);
        radix16<false>(e);
#pragma unroll
        for (int m = 0; m < 16; ++m) e[m] = cmul(e[m], hreg[m]);
        radix16<true>(e);
        st16(e, p);
        __builtin_amdgcn_sched_barrier(0);
    }
    __syncthreads();
    asm volatile("" : "+v"(tid));
    fft_pass8x2<true, 6, false, false>(XA, XB, tw, tid); fft_pass8x2<true, 9, false, false>(XA, XB, tw, tid); fft_pass8x2<true, 12, false, true>(XA, XB, tw, tid);
}

struct HyRaw { u32x4 q; unsigned lr; };
__device__ __forceinline__ void hy_raw_load(HyRaw& R, const bf16_t* __restrict__ zrow, int t0) {
    R.q = *(const u32x4*)(zrow + t0);
    const unsigned l = t0 > 0 ? (unsigned)zrow[t0 - 1] : 0u, r = t0 + 8 < SEQ ? (unsigned)zrow[t0 + 8] : 0u;
    R.lr = l | (r << 16);
}
__device__ __forceinline__ void hy_sc8(float (&out)[8], const HyRaw& R, float w0, float w1, float w2, float cb) {
    float z[10];
    z[0] = bflo(R.lr); z[1] = bflo(R.q.x); z[2] = bfhi(R.q.x); z[3] = bflo(R.q.y); z[4] = bfhi(R.q.y); z[5] = bflo(R.q.z); z[6] = bfhi(R.q.z); z[7] = bflo(R.q.w); z[8] = bfhi(R.q.w); z[9] = bfhi(R.lr);
#pragma unroll
    for (int e = 0; e < 8; ++e) out[e] = z[e] * w0 + z[e + 1] * w1 + z[e + 2] * w2 + cb;
}
struct HyF { u32x4 a, b; };
__device__ __forceinline__ void hy_f_load(HyF& f, const bf16_t* __restrict__ F, int col_f, int col_b, int t0) {
    f.a = *(const u32x4*)(F + (size_t)col_f * 4096 + t0); f.b = *(const u32x4*)(F + (size_t)col_b * 4096 + t0);
}
__device__ __forceinline__ void hy_filter(LAS f32x2* Hs, const HyF& f, int t0, int xo, const LAS f32x2* twl, f32x2 (&hreg)[16]) {
    __syncthreads();
    f32x4 w; w[1] = 0.f; w[3] = 0.f;
    w[0] = bflo(f.a.x); w[2] = bfhi(f.a.x); *(LAS f32x4*)(Hs + xo) = w; w[0] = bflo(f.a.y); w[2] = bfhi(f.a.y); *(LAS f32x4*)(Hs + xo + 2) = w;
    w[0] = bflo(f.a.z); w[2] = bfhi(f.a.z); *(LAS f32x4*)(Hs + xo + 4) = w; w[0] = bflo(f.a.w); w[2] = bfhi(f.a.w); *(LAS f32x4*)(Hs + xo + 6) = w;
    float fb[8];
    fb[0] = bflo(f.b.x); fb[1] = bfhi(f.b.x); fb[2] = bflo(f.b.y); fb[3] = bfhi(f.b.y); fb[4] = bflo(f.b.z); fb[5] = bfhi(f.b.z); fb[6] = bflo(f.b.w); fb[7] = bfhi(f.b.w);
#pragma unroll
    for (int e = 0; e < 8; ++e) {
        const int l = t0 + e; f32x2 v; v.y = 0.f; v.x = fb[e];
        if (l >= 1) Hs[FP(8192 - l)] = v; else { v.x = 0.f; Hs[FP(4096)] = v; }
    }
    __syncthreads();
    fft_fwd_regs(Hs, twl, hreg);
}
__device__ __forceinline__ void hy_stage(LAS f32x2* X, int xo, const float (&v0)[8], const float (&v1)[8]) {
#pragma unroll
    for (int e = 0; e < 8; e += 2) { f32x4 w; w[0] = v0[e]; w[1] = v1[e]; w[2] = v0[e + 1]; w[3] = v1[e + 1]; *(LAS f32x4*)(X + xo + e) = w; }
}
__device__ __forceinline__ void hy_finish(const LAS f32x2* X, int xo, const float (&v0)[8], const float (&v1)[8], const float (&g0)[8], const float (&g1)[8], float sk, float (&r0)[8], float (&r1)[8]) {
#pragma unroll
    for (int e = 0; e < 8; e += 2) {
        const f32x4 c = *(const LAS f32x4*)(X + xo + e);
        r0[e] = g0[e] * (c[0] * (1.0f / 8192.0f) + v0[e] * sk); r1[e] = g1[e] * (c[1] * (1.0f / 8192.0f) + v1[e] * sk);
        r0[e + 1] = g0[e + 1] * (c[2] * (1.0f / 8192.0f) + v0[e + 1] * sk); r1[e + 1] = g1[e + 1] * (c[3] * (1.0f / 8192.0f) + v1[e + 1] * sk);
    }
}
__device__ __forceinline__ void st8_bf16(bf16_t* p, const float (&r)[8]) { u32x4 w; w.x = cvt_pk_bf16(r[0], r[1]); w.y = cvt_pk_bf16(r[2], r[3]); w.z = cvt_pk_bf16(r[4], r[5]); w.w = cvt_pk_bf16(r[6], r[7]); *(u32x4*)p = w; }

__device__ __forceinline__ void ph_hyena(LAS unsigned char* lds, const bf16_t* __restrict__ ZT, const float* __restrict__ conv_w, const float* __restrict__ conv_b,
                                         const bf16_t* __restrict__ F, const float* __restrict__ skip, const f32x2* __restrict__ tw, bf16_t* __restrict__ Y2T) {
    LAS f32x2* XA = (LAS f32x2*)lds;
    LAS f32x2* XB = (LAS f32x2*)(lds + FFT_BUF_BYTES);
    LAS f32x2* twl = (LAS f32x2*)(lds + LDS_TWL);
    const int tid = threadIdx.x, t0 = tid * 8;
    const int xo = FP(t0);
    __syncthreads();
    for (int i = tid; i < 1024; i += NTHREADS) twl[i] = tw[i];
    HyF fc; HyRaw rv[4], rg[4], rg2[4];
    int ch = blockIdx.x;
    if (ch < DM) {
        hy_f_load(fc, F, ch, 2 * DM + ch, t0);
#pragma unroll
        for (int b = 0; b < 4; ++b) hy_raw_load(rv[b], ZT + (size_t)(2 * DM + ch) * RL + b * SEQ, t0);
    }
#pragma unroll 1
    for (; ch < DM; ch += gridDim.x) {
        const int cv = 2 * DM + ch, cx1 = ch, cx2 = DM + ch;
        const float vw0 = conv_w[cv], vw1 = conv_w[3 * DM + cv], vw2 = conv_w[6 * DM + cv], vb = conv_b[cv];
        const float aw0 = conv_w[cx1], aw1 = conv_w[3 * DM + cx1], aw2 = conv_w[6 * DM + cx1], ab = conv_b[cx1];
        const float bw0 = conv_w[cx2], bw1 = conv_w[3 * DM + cx2], bw2 = conv_w[6 * DM + cx2], bb = conv_b[cx2];
        const float sk0 = skip[ch], sk1 = skip[DM + ch];
        f32x2 hreg[16];
        float v[4][8], g0[8], g1[8];
        hy_filter(XB, fc, t0, xo, twl, hreg);
#pragma unroll
        for (int b = 0; b < 4; ++b) hy_sc8(v[b], rv[b], vw0, vw1, vw2, vb);
        hy_stage(XA, xo, v[0], v[1]); hy_stage(XB, xo, v[2], v[3]);
        hy_f_load(fc, F, DM + ch, 3 * DM + ch, t0);
#pragma unroll
        for (int b = 0; b < 4; ++b) { hy_raw_load(rg[b], ZT + (size_t)cx1 * RL + b * SEQ, t0); hy_raw_load(rg2[b], ZT + (size_t)cx2 * RL + b * SEQ, t0); }
        __syncthreads();
        fft_conv2(XA, XB, hreg, twl);
        hy_sc8(g0, rg[0], aw0, aw1, aw2, ab); hy_sc8(g1, rg[1], aw0, aw1, aw2, ab);
        hy_finish(XA, xo, v[0], v[1], g0, g1, sk0, v[0], v[1]);
        hy_sc8(g0, rg[2], aw0, aw1, aw2, ab); hy_sc8(g1, rg[3], aw0, aw1, aw2, ab);
        hy_finish(XB, xo, v[2], v[3], g0, g1, sk0, v[2], v[3]);
        hy_filter(XB, fc, t0, xo, twl, hreg);
        hy_stage(XA, xo, v[0], v[1]); hy_stage(XB, xo, v[2], v[3]);
        {
            const int cn = ch + (int)gridDim.x;
            if (cn < DM) {
                hy_f_load(fc, F, cn, 2 * DM + cn, t0);
#pragma unroll
                for (int b = 0; b < 4; ++b) hy_raw_load(rv[b], ZT + (size_t)(2 * DM + cn) * RL + b * SEQ, t0);
            }
        }
        __syncthreads();
        fft_conv2(XA, XB, hreg, twl);
        {
            float r0[8], r1[8];
            hy_sc8(g0, rg2[0], bw0, bw1, bw2, bb); hy_sc8(g1, rg2[1], bw0, bw1, bw2, bb);
            hy_finish(XA, xo, v[0], v[1], g0, g1, sk1, r0, r1);
            st8_bf16(Y2T + (size_t)ch * RL + 0 * SEQ + t0, r0); st8_bf16(Y2T + (size_t)ch * RL + 1 * SEQ + t0, r1);
            hy_sc8(g0, rg2[2], bw0, bw1, bw2, bb); hy_sc8(g1, rg2[3], bw0, bw1, bw2, bb);
            hy_finish(XB, xo, v[2], v[3], g0, g1, sk1, r0, r1);
            st8_bf16(Y2T + (size_t)ch * RL + 2 * SEQ + t0, r0); st8_bf16(Y2T + (size_t)ch * RL + 3 * SEQ + t0, r1);
        }
    }
}

constexpr int N_IN = 37;
enum { I_X = 0, I_C, I_CTX, I_CCTX, I_ADAW, I_ADAB, I_NORMG, I_W1, I_W2, I_SWQKV, I_SWSINK, I_SWWO, I_MLWIN, I_MLGB, I_MLHG, I_MLWO,
       I_MAWIN, I_MAQG, I_MAKVG, I_MAUQ, I_MAUKV, I_MAWO, I_HYWIN, I_HYCW, I_HYCB, I_HYW1, I_HYB1, I_HYW2, I_HYB2, I_HYW3, I_HYB3, I_HYW4, I_HYB4, I_HYFREQ, I_HYDECAY, I_HYSKIP, I_HYWO };
struct Args { const float* in[N_IN]; float* out; unsigned char* ws; int ph_lo, ph_hi; };
constexpr int N_PHASES = 36;

__global__ void __launch_bounds__(NTHREADS, 2) mk_fwd(Args args) {
    extern __shared__ __attribute__((aligned(16))) unsigned char lds_raw[];
    LAS unsigned char* lds = (LAS unsigned char*)lds_raw;
    unsigned char* ws = args.ws;
    const int tid = threadIdx.x;
    volatile LAS unsigned* misc = (volatile LAS unsigned*)(lds + LDS_MISC);
    if (tid < 4) misc[tid] = 0u;
    __syncthreads();
#if MK_ONE_LAUNCH
    XcdBarrier bar = xcd_barrier_post((unsigned*)(ws + WS_CTL), misc);
#define GRID_BAR() xcd_barrier(bar)
    if (tid == 0) { const unsigned xc = xb_xcc_id(); misc[4] = xc; misc[5] = xb_add((unsigned*)(ws + WS_CTL) + 3712 + xc, 1u); }
#else
#define GRID_BAR() do {} while (0)
#endif
    const int lo = args.ph_lo, hi = args.ph_hi;
#define IN(k) (lo <= (k) && (k) < hi)
#define SEAM(k) do { if (IN(k) && IN((k) + 1)) GRID_BAR(); } while (0)
#define PH_BEGIN(k) if (IN(k)) { _Pragma("unroll") for (int rep_ = 0; rep_ < 1; ++rep_) {
#define PH_END(k) } }

    const float* x = args.in[I_X]; const float* cin = args.in[I_CTX];
    float* mods = (float*)(ws + WS_MODS);
    const f32x2* ropeA = (const f32x2*)(ws + WS_ROPEA); const f32x2* ropeC = (const f32x2*)(ws + WS_ROPEC); const f32x2* tw = (const f32x2*)(ws + WS_TW);
    bf16_t* a3b = (bf16_t*)(ws + WS_A3T); bf16_t* w4tb = (bf16_t*)(ws + WS_W4TB);
    bf16_t* W1T = (bf16_t*)(ws + WS_W1T); bf16_t* W2T = (bf16_t*)(ws + WS_W2T);
    bf16_t* H = (bf16_t*)(ws + WS_H); bf16_t* U = (bf16_t*)(ws + WS_U); bf16_t* Y = (bf16_t*)(ws + WS_Y); bf16_t* YP = (bf16_t*)(ws + WS_YP); bf16_t* O = (bf16_t*)(ws + WS_O); bf16_t* T = (bf16_t*)(ws + WS_T);
    const float* normg = args.in[I_NORMG];
    constexpr float LOG2E = 1.4426950408889634f;

    PH_BEGIN(0)
        {
        ph_mods(lds, args.in[I_C], args.in[I_CCTX], args.in[I_ADAW], args.in[I_ADAB], mods, 0, 192, (int)blockIdx.x, (int)gridDim.x);
        __syncthreads();
        ph_tables((f32x2*)(ws + WS_ROPEA), (f32x2*)(ws + WS_ROPEC), (f32x2*)(ws + WS_TW));
        ph_hyena_feats(lds, args.in[I_HYW1], args.in[I_HYB1], args.in[I_HYW2], args.in[I_HYB2], args.in[I_HYW3], args.in[I_HYB3], args.in[I_HYFREQ], a3b);
        conv_w4(args.in[I_HYW4], w4tb);
        __syncthreads();
        const int pr = (int)blockIdx.x, pn = (int)gridDim.x;
        conv_weight(lds, args.in[I_SWQKV], (bf16_t*)(ws + WS_QKVT), DM, 3072, 3072, 1, 0, 1.f, pr, pn);
        conv_weight(lds, args.in[I_SWWO], (bf16_t*)(ws + WS_SWOT), DM, DM, DM, 0, 0, 1.f, pr, pn);
        conv_weight(lds, args.in[I_W1], W1T, DM, FF, FF, 0, 0, 1.f, pr, pn);
        conv_weight(lds, args.in[I_W2], W2T, FF, DM, DM, 0, 0, 1.f, pr, pn);
        conv_weight(lds, args.in[I_W1] + (size_t)3 * DM * FF, W1T + (size_t)3 * FF * DM, DM, FF, FF, 0, 0, 1.f, pr, pn);
        conv_weight(lds, args.in[I_W2] + (size_t)3 * FF * DM, W2T + (size_t)3 * DM * FF, FF, DM, DM, 0, 0, 1.f, pr, pn);
    }
    PH_END(0)
    SEAM(0);
    int vbid = (int)blockIdx.x;
#if MK_ONE_LAUNCH
    if (IN(0) && IN(1)) {
        if (tid == 0) {
            const unsigned xc = misc[4], rk = misc[5]; unsigned p_ = rk;
            for (unsigned j = 0; j < 16; ++j) { const unsigned cj = xb_ld((unsigned*)(ws + WS_CTL) + 3712 + j); if (j < xc) p_ += cj; }
            const unsigned G_ = gridDim.x, per = G_ >> 3;
            misc[6] = ((G_ & 7u) == 0u && p_ < G_) ? (p_ % per) * 8u + p_ / per : blockIdx.x;
        }
        __syncthreads();
        vbid = (int)misc[6];
    }
#endif
    const int xlid = (gridDim.x == 256) ? (vbid & 7) * 32 + (vbid >> 3) : (int)blockIdx.x;
    PH_BEGIN(1)
        ph_normmod(x, cin, nullptr, true, normg + (0 * 4 + 0) * DM, mods + (size_t)0 * 5 * NMOD, 0, 1, U, RA);
    PH_END(1)
    SEAM(1);
    PH_BEGIN(2)
        {
        EpiG<0> e = mk_epi<0>(ws + WS_QKV, 3072); e.rope = ropeA; e.head_w = 128; e.rope_off = 0; e.rope_cols = 2560; e.tab_stride = 64; e.rope_rows = RL;
        run_gemm<0>(lds, U, (const bf16_t*)(ws + WS_QKVT), RA, 3072, DM, e, vbid);
        int tr_, tn_;
        if (tail_slot((RA / 256) * 12, vbid, tr_, tn_)) {
            __syncthreads();
            conv_weight(lds, args.in[I_MLWIN], (bf16_t*)(ws + WS_MLIN), DM, 6176, 6400, 0, 1024, 0.08838834764831845f, tr_, tn_);
            conv_weight(lds, args.in[I_MLWO], (bf16_t*)(ws + WS_MLO), DM, DM, DM, 0, 0, 1.f, tr_, tn_);
            conv_weight(lds, args.in[I_W1] + (size_t)1 * DM * FF, W1T + (size_t)1 * FF * DM, DM, FF, FF, 0, 0, 1.f, tr_, tn_);
        }
    }
    PH_END(2)
    SEAM(2);
    PH_BEGIN(3)
        {
        const bf16_t* qkv = (const bf16_t*)(ws + WS_QKV);
        const float* sink = args.in[I_SWSINK];
        const float sc = 0.08838834764831845f * LOG2E;
#pragma unroll 1
        for (int ui = blockIdx.x; ui < 1024 + 64; ui += gridDim.x) {
            if (ui < 1024) {
                int u = ui;
                if (gridDim.x == 256) { const int rnd = ui >> 8, xc = vbid & 7, rk = vbid >> 3; u = ((rnd * 8 + xc) << 5) + rk; }
                const int qb = u & 63, kvh = (u >> 6) & 3, b = u >> 8;
                const int t0 = qb * 64, ks = t0 - 128 < 0 ? 0 : t0 - 128, ke = t0 + 192 > SEQ ? SEQ : t0 + 192;
                const int qrow0 = b * SEQ + t0, hq0 = kvh * 4;
                attn_unit<128>(lds, qkv + (size_t)qrow0 * 3072 + hq0 * 128, 3072, qkv + 2048 + kvh * 128, 3072, nullptr, qkv + 2560 + kvh * 128, 3072,
                               b * SEQ + ks, (ke - ks) >> 6, RL + b * CTX, 4, true, ks, t0, sc, true, 0.f, O + (size_t)qrow0 * DM + hq0 * 128, DM, true, sink + hq0);
            } else {
                const int v = ui - 1024, hq = v & 15, b = v >> 4, kvh = hq >> 2, qrow0 = RL + b * CTX;
                attn_unit<128>(lds, qkv + (size_t)qrow0 * 3072 + hq * 128, 3072, qkv + 2048 + kvh * 128, 3072, nullptr, qkv + 2560 + kvh * 128, 3072,
                               0, 0, RL + b * CTX, 4, true, 0, 0, sc, true, sink[hq] * LOG2E, O + (size_t)qrow0 * DM + hq * 128, DM);
            }
        }
        int tr_, tn_;
        if (tail_slot(1024 + 64, (int)blockIdx.x, tr_, tn_)) { __syncthreads(); ph_mods(lds, args.in[I_C], args.in[I_CCTX], args.in[I_ADAW], args.in[I_ADAB], mods, 192, 384, tr_, tn_); }
    }
    PH_END(3)
    SEAM(3);
    PH_BEGIN(4)
        { EpiG<0> e = mk_epi<0>(Y, DM); run_gemm<0>(lds, O, (const bf16_t*)(ws + WS_SWOT), RL, DM, DM, e, vbid);
          run_gemm_split(lds, O + (size_t)RL * DM, (const bf16_t*)(ws + WS_SWOT), NB * CTX, DM, DM, 8, YP, vbid); }
    PH_END(4)
    SEAM(4);
    PH_BEGIN(5)
        ph_resid<true, false>(lds, Y, YP, normg + (0 * 4 + 1) * DM, mods + (size_t)0 * 5 * NMOD, 2, x, cin, H, H, true, normg + (0 * 4 + 2) * DM, mods + (size_t)0 * 5 * NMOD, 3, 4, U, RA);
    PH_END(5)
    SEAM(5);
    PH_BEGIN(6)
        { EpiG<1> e = mk_epi<1>(T, FF); run_gemm<1, 0, 4>(lds, U, W1T + (size_t)0 * FF * DM, RA, FF, DM, e, vbid);
          int tr_, tn_;
          if (tail_slot((RA / 256) * 32, vbid, tr_, tn_)) {
              __syncthreads();
              conv_weight(lds, args.in[I_W2] + (size_t)1 * FF * DM, W2T + (size_t)1 * DM * FF, FF, DM, DM, 0, 0, 1.f, tr_, tn_);
          } }
    PH_END(6)
    SEAM(6);
    PH_BEGIN(7)
        { EpiG<0> e = mk_epi<0>(Y, DM); run_gemm<0, 0, 4>(lds, T, W2T + (size_t)0 * DM * FF, RL, DM, FF, e, vbid);
          run_gemm_split(lds, T + (size_t)RL * FF, W2T + (size_t)0 * DM * FF, NB * CTX, DM, FF, 8, YP, vbid); }
    PH_END(7)
    SEAM(7);
    PH_BEGIN(8)
        ph_resid<false, false>(lds, Y, YP, normg + (0 * 4 + 3) * DM, mods + (size_t)0 * 5 * NMOD, 5, x, cin, H, H, true, normg + (1 * 4 + 0) * DM, mods + (size_t)1 * 5 * NMOD, 0, 1, U, RA);
    PH_END(8)
    SEAM(8);
    PH_BEGIN(9)
        { EpiG<0> e = mk_epi<0>(ws + WS_Z1, 6400); run_gemm<0>(lds, U, (const bf16_t*)(ws + WS_MLIN), RA, 6400, DM, e, vbid);
          int tr_, tn_;
          if (tail_slot((RA / 256) * 25, vbid, tr_, tn_)) {
              __syncthreads();
              conv_weight(lds, args.in[I_MAWIN], (bf16_t*)(ws + WS_MAIN), DM, 1088, 1280, 2, 0, 1.f, tr_, tn_);
              conv_weight(lds, args.in[I_MAUQ], (bf16_t*)(ws + WS_MUQ), 512, 3072, 3072, 3, 0, 1.f, tr_, tn_);
              conv_weight(lds, args.in[I_MAUKV], (bf16_t*)(ws + WS_MUKV), 512, 4096, 4096, 0, 0, 1.f, tr_, tn_);
              conv_weight(lds, args.in[I_MAWO], (bf16_t*)(ws + WS_MAO), DM, DM, DM, 0, 0, 1.f, tr_, tn_);
          } }
    PH_END(9)
    SEAM(9);
    PH_BEGIN(10)
        { ph_ml_p1(lds, (const bf16_t*)(ws + WS_Z1), args.in[I_MLGB], (bf16_t*)(ws + WS_DC), (float*)(ws + WS_DN), (float*)(ws + WS_AC), (float*)(ws + WS_GB), xlid);
          int tr_, tn_;
          if (tail_slot(1088, xlid, tr_, tn_)) { __syncthreads(); ph_mods(lds, args.in[I_C], args.in[I_CCTX], args.in[I_ADAW], args.in[I_ADAB], mods, 384, 576, tr_, tn_); } }
    PH_END(10)
    SEAM(10);
    PH_BEGIN(11)
        ph_ml_p2((const bf16_t*)(ws + WS_DC), (const float*)(ws + WS_DN), (const float*)(ws + WS_AC), (bf16_t*)(ws + WS_CS), (float*)(ws + WS_NS));
    PH_END(11)
    SEAM(11);
    PH_BEGIN(12)
        { ph_ml_p3(lds, (const bf16_t*)(ws + WS_Z1), (const float*)(ws + WS_GB), (const bf16_t*)(ws + WS_CS), (const float*)(ws + WS_NS), (bf16_t*)(ws + WS_HD), xlid);
          int tr_, tn_;
          if (tail_slot(2176, xlid, tr_, tn_)) { __syncthreads(); ph_mods(lds, args.in[I_C], args.in[I_CCTX], args.in[I_ADAW], args.in[I_ADAB], mods, 576, 704, tr_, tn_); } }
    PH_END(12)
    SEAM(12);
    PH_BEGIN(13)
        ph_headnorm((const bf16_t*)(ws + WS_HD), (const bf16_t*)(ws + WS_HD) + (size_t)RA * DM, (const bf16_t*)(ws + WS_Z1), args.in[I_MLHG], O);
    PH_END(13)
    SEAM(13);
    PH_BEGIN(14)
        { EpiG<0> e = mk_epi<0>(Y, DM); run_gemm<0>(lds, O, (const bf16_t*)(ws + WS_MLO), RL, DM, DM, e, vbid);
          run_gemm_split(lds, O + (size_t)RL * DM, (const bf16_t*)(ws + WS_MLO), NB * CTX, DM, DM, 8, YP, vbid); }
    PH_END(14)
    SEAM(14);
    PH_BEGIN(15)
        ph_resid<false, false>(lds, Y, YP, normg + (1 * 4 + 1) * DM, mods + (size_t)1 * 5 * NMOD, 2, x, cin, H, H, true, normg + (1 * 4 + 2) * DM, mods + (size_t)1 * 5 * NMOD, 3, 4, U, RA);
    PH_END(15)
    SEAM(15);
    PH_BEGIN(16)
        { EpiG<1> e = mk_epi<1>(T, FF); run_gemm<1, 0, 4>(lds, U, W1T + (size_t)1 * FF * DM, RA, FF, DM, e, vbid);
          int tr_, tn_;
          if (tail_slot((RA / 256) * 32, vbid, tr_, tn_)) {
              __syncthreads();
              ph_mods(lds, args.in[I_C], args.in[I_CCTX], args.in[I_ADAW], args.in[I_ADAB], mods, 704, 768, tr_, tn_);
              __syncthreads();
              conv_weight(lds, args.in[I_W1] + (size_t)2 * DM * FF, W1T + (size_t)2 * FF * DM, DM, FF, FF, 0, 0, 1.f, tr_, tn_);
          } }
    PH_END(16)
    SEAM(16);
    PH_BEGIN(17)
        { EpiG<0> e = mk_epi<0>(Y, DM); run_gemm<0, 0, 4>(lds, T, W2T + (size_t)1 * DM * FF, RL, DM, FF, e, vbid);
          run_gemm_split(lds, T + (size_t)RL * FF, W2T + (size_t)1 * DM * FF, NB * CTX, DM, FF, 8, YP, vbid); }
    PH_END(17)
    SEAM(17);
    PH_BEGIN(18)
        ph_resid<false, false>(lds, Y, YP, normg + (1 * 4 + 3) * DM, mods + (size_t)1 * 5 * NMOD, 5, x, cin, H, H, true, normg + (2 * 4 + 0) * DM, mods + (size_t)2 * 5 * NMOD, 0, 1, U, RA);
    PH_END(18)
    SEAM(18);
    PH_BEGIN(19)
        { EpiG<0> e = mk_epi<0>(ws + WS_Z2, 1280); run_gemm<0>(lds, U, (const bf16_t*)(ws + WS_MAIN), RA, 1280, DM, e, vbid);
          int tr_, tn_;
          if (tail_slot((RA / 256) * 5, vbid, tr_, tn_)) {
              __syncthreads();
              conv_weight(lds, args.in[I_W2] + (size_t)2 * FF * DM, W2T + (size_t)2 * DM * FF, FF, DM, DM, 0, 0, 1.f, tr_, tn_);
              conv_weight(lds, args.in[I_HYWIN], (bf16_t*)(ws + WS_HYIN), DM, 6144, 6144, 0, 0, 1.f, tr_, tn_);
          } }
    PH_END(19)
    SEAM(19);
    PH_BEGIN(20)
        ph_mla_rows((const bf16_t*)(ws + WS_Z2), args.in[I_MAQG], args.in[I_MAKVG], ropeC, (bf16_t*)(ws + WS_ZQ), (bf16_t*)(ws + WS_ZKV), (bf16_t*)(ws + WS_KR));
    PH_END(20)
    SEAM(20);
    PH_BEGIN(21)
        {
        { EpiG<0> e = mk_epi<0>(ws + WS_Q2, 3072); e.rope = ropeC; e.head_w = 192; e.rope_off = 128; e.rope_cols = 3072; e.tab_stride = 32; e.rope_rows = RL;
          run_gemm<0>(lds, (const bf16_t*)(ws + WS_ZQ), (const bf16_t*)(ws + WS_MUQ), RL, 3072, 512, e, vbid); }
        { EpiG<0> e = mk_epi<0>(ws + WS_KV, 4096); run_gemm<0>(lds, (const bf16_t*)(ws + WS_ZKV), (const bf16_t*)(ws + WS_MUKV), RA, 4096, 512, e, vbid); }
        int tr_, tn_;
        if (tail_slot((RA / 256) * 16, vbid, tr_, tn_)) {
            __syncthreads();
            conv_weight(lds, args.in[I_HYWO], (bf16_t*)(ws + WS_HYO), DM, DM, DM, 0, 0, 1.f, tr_, tn_);
        }
    }
    PH_END(21)
    SEAM(21);
    PH_BEGIN(22)
        {
        const bf16_t* q2 = (const bf16_t*)(ws + WS_Q2); const bf16_t* kv = (const bf16_t*)(ws + WS_KV); const bf16_t* kr = (const bf16_t*)(ws + WS_KR);
        const float sc = 0.07216878364870323f * LOG2E;
#pragma unroll 1
        for (int ui = blockIdx.x; ui < 1024; ui += gridDim.x) {
            int u = ui;
            if (gridDim.x == 256) { const int rnd = ui >> 8, xc = vbid & 7, rk = vbid >> 3; u = (((rnd * 8 + xc) * 2 + (rk >> 4)) << 4) + (rk & 15); }
            const int qb = u & 15, hh = (u >> 4) & 15, b = u >> 8;
            const int qrow0 = b * SEQ + qb * 256;
            attn_unit<192>(lds, q2 + (size_t)qrow0 * 3072 + hh * 192, 3072, kv + hh * 256, 4096, kr, kv + hh * 256 + 128, 4096,
                           b * SEQ, 64, RL + b * CTX, 4, false, 0, 0, sc, false, 0.f, O + (size_t)qrow0 * DM + hh * 128, DM);
        }
    }
    PH_END(22)
    SEAM(22);
    PH_BEGIN(23)
        { EpiG<0> e = mk_epi<0>(Y, DM); run_gemm<0>(lds, O, (const bf16_t*)(ws + WS_MAO), RL, DM, DM, e, vbid); }
    PH_END(23)
    SEAM(23);
    PH_BEGIN(24)
        ph_resid<false, false>(lds, Y, nullptr, normg + (2 * 4 + 1) * DM, mods + (size_t)2 * 5 * NMOD, 2, x, cin, H, H, true, normg + (2 * 4 + 2) * DM, mods + (size_t)2 * 5 * NMOD, 3, 4, U, RL);
    PH_END(24)
    SEAM(24);
    PH_BEGIN(25)
        { EpiG<1> e = mk_epi<1>(T, FF); run_gemm<1, 0, 4>(lds, U, W1T + (size_t)2 * FF * DM, RL, FF, DM, e, vbid); }
    PH_END(25)
    SEAM(25);
    PH_BEGIN(26)
        { EpiG<0> e = mk_epi<0>(Y, DM); run_gemm<0, 0, 4>(lds, T, W2T + (size_t)2 * DM * FF, RL, DM, FF, e, vbid); }
    PH_END(26)
    SEAM(26);
    PH_BEGIN(27)
        {
        ph_resid<false, false>(lds, Y, nullptr, normg + (2 * 4 + 3) * DM, mods + (size_t)2 * 5 * NMOD, 5, x, cin, H, H, true, normg + (3 * 4 + 0) * DM, mods + (size_t)3 * 5 * NMOD, 0, 1, U, RL);
        __syncthreads();
        run_gemm_filt(lds, w4tb, a3b, (bf16_t*)(ws + WS_F), args.in[I_HYB4], args.in[I_HYDECAY], vbid);
        }
    PH_END(27)
    SEAM(27);
    PH_BEGIN(28)
        { EpiG<0> e = mk_epi<0>(ws + WS_ZT, RL); run_gemm<0>(lds, (const bf16_t*)(ws + WS_HYIN), U, 6144, RL, DM, e, vbid); }
    PH_END(28)
    SEAM(28);
    PH_BEGIN(29)
        ph_hyena(lds, (const bf16_t*)(ws + WS_ZT), args.in[I_HYCW], args.in[I_HYCB], (const bf16_t*)(ws + WS_F), args.in[I_HYSKIP], tw, (bf16_t*)(ws + WS_Y2T));
    PH_END(29)
    SEAM(29);
    PH_BEGIN(30)
        ph_transpose(lds, (const bf16_t*)(ws + WS_Y2T), O);
    PH_END(30)
    SEAM(30);
    PH_BEGIN(31)
        { EpiG<0> e = mk_epi<0>(Y, DM); run_gemm<0>(lds, O, (const bf16_t*)(ws + WS_HYO), RL, DM, DM, e, vbid); }
    PH_END(31)
    SEAM(31);
    PH_BEGIN(32)
        ph_resid<false, false>(lds, Y, nullptr, normg + (3 * 4 + 1) * DM, mods + (size_t)3 * 5 * NMOD, 2, x, cin, H, H, true, normg + (3 * 4 + 2) * DM, mods + (size_t)3 * 5 * NMOD, 3, 4, U, RL);
    PH_END(32)
    SEAM(32);
    PH_BEGIN(33)
        { EpiG<1> e = mk_epi<1>(T, FF); run_gemm<1, 0, 4>(lds, U, W1T + (size_t)3 * FF * DM, RL, FF, DM, e, vbid); }
    PH_END(33)
    SEAM(33);
    PH_BEGIN(34)
        {
        EpiG<0> e = mk_epi<0>(Y, DM); run_gemm<0, 0, 4>(lds, T, W2T + (size_t)3 * DM * FF, RL, DM, FF, e, vbid);
        }
    PH_END(34)
    SEAM(34);
    PH_BEGIN(35)
        ph_resid<false, true>(lds, Y, nullptr, normg + (3 * 4 + 3) * DM, mods + (size_t)3 * 5 * NMOD, 5, x, cin, H, args.out, false, nullptr, nullptr, 0, 0, nullptr, RL);
    PH_END(35)
#undef IN
#undef SEAM
}

extern "C" void kernel_launch(void* const* d_in, const int* in_sizes, int n_in, void* d_out, int out_size, void* d_ws, size_t ws_size, hipStream_t stream) {
    static int grid = 0;
    if (grid == 0) {
        if (n_in != N_IN || ws_size < WS_END) { fprintf(stderr, "kernel_launch: expected %d inputs and >= %zu bytes of workspace, got %d / %zu\n", N_IN, (size_t)WS_END, n_in, ws_size); grid = -1; return; }
        int dev = 0, cus = 0, per_cu = 0;
        if (hipGetDevice(&dev) != hipSuccess || hipDeviceGetAttribute(&cus, hipDeviceAttributeMultiprocessorCount, dev) != hipSuccess) { grid = -1; return; }
        if (hipFuncSetAttribute((const void*)mk_fwd, hipFuncAttributeMaxDynamicSharedMemorySize, LDS_BYTES) != hipSuccess) { fprintf(stderr, "kernel_launch: hipFuncSetAttribute failed\n"); grid = -1; return; }
        if (hipOccupancyMaxActiveBlocksPerMultiprocessor(&per_cu, (const void*)mk_fwd, NTHREADS, LDS_BYTES) != hipSuccess || per_cu < 1) { fprintf(stderr, "kernel_launch: occupancy query says %d blocks per CU\n", per_cu); }
        (void)hipGetLastError();
        grid = cus;
    }
    if (grid < 0) return;
    (void)hipMemsetAsync((char*)d_ws + WS_CTL, 0, 16384, stream);
    Args a{};
    for (int i = 0; i < N_IN; ++i) a.in[i] = (const float*)d_in[i];
    a.out = (float*)d_out; a.ws = (unsigned char*)d_ws;
#if MK_ONE_LAUNCH
    a.ph_lo = 0; a.ph_hi = N_PHASES;
    hipLaunchKernelGGL(mk_fwd, dim3(grid), dim3(NTHREADS), LDS_BYTES, stream, a);
#else
    for (int p = 0; p < N_PHASES; ++p) { a.ph_lo = p; a.ph_hi = p + 1; hipLaunchKernelGGL(mk_fwd, dim3(grid), dim3(NTHREADS), LDS_BYTES, stream, a); }
#endif
}
```

```cpp
#include <hip/hip_runtime.h>
#include <stdint.h>
#include <stdio.h>

#ifndef MK_ONE_LAUNCH
#define MK_ONE_LAUNCH 1
#endif

typedef unsigned short bf16_t;
typedef short bf16x8 __attribute__((ext_vector_type(8)));
typedef short s16x4 __attribute__((ext_vector_type(4)));
typedef float f32x4 __attribute__((ext_vector_type(4)));
typedef float f32x2 __attribute__((ext_vector_type(2)));
typedef float f32x16 __attribute__((ext_vector_type(16)));
typedef unsigned u32x4 __attribute__((ext_vector_type(4)));
typedef unsigned u32x2 __attribute__((ext_vector_type(2)));
#define LAS __attribute__((address_space(3)))

constexpr int DM = 2048, NB = 4, SEQ = 4096, CTX = 256, FF = 8192;
constexpr int RL = NB * SEQ;
constexpr int RA = RL + NB * CTX;
constexpr int NMOD = 6 * DM;
constexpr float RMS_EPS = 1e-6f;
constexpr int NTHREADS = 512, NWAVES = 8;
constexpr int LDS_BYTES = 147456 + 512 + 8192;
constexpr int LDS_MISC = 147456;
constexpr int LDS_TWL  = 147456 + 512;

constexpr size_t al256(size_t x) { return (x + 255) & ~(size_t)255; }
constexpr size_t WS_CTL   = 0;
constexpr size_t WS_MODS  = 16384;
constexpr size_t WS_ROPEA = WS_MODS + al256((size_t)4 * 5 * NMOD * 4);
constexpr size_t WS_ROPEC = WS_ROPEA + (size_t)4096 * 64 * 8;
constexpr size_t WS_TW    = WS_ROPEC + (size_t)4096 * 32 * 8;
constexpr size_t WS_A3T   = WS_TW + (size_t)8192 * 8;
constexpr size_t WS_W4TB  = WS_A3T + (size_t)4096 * 256 * 2;
constexpr size_t WS_W1T   = WS_W4TB + (size_t)8192 * 256 * 2;
constexpr size_t WS_W2T   = WS_W1T + (size_t)4 * FF * DM * 2;
constexpr size_t WS_QKVT  = WS_W2T + (size_t)4 * FF * DM * 2;
constexpr size_t WS_SWOT  = WS_QKVT + (size_t)3072 * DM * 2;
constexpr size_t WS_MLIN  = WS_SWOT + (size_t)DM * DM * 2;
constexpr size_t WS_MLO   = WS_MLIN + (size_t)6400 * DM * 2;
constexpr size_t WS_MAIN  = WS_MLO + (size_t)DM * DM * 2;
constexpr size_t WS_MUQ   = WS_MAIN + (size_t)1280 * DM * 2;
constexpr size_t WS_MUKV  = WS_MUQ + (size_t)3072 * 512 * 2;
constexpr size_t WS_MAO   = WS_MUKV + (size_t)4096 * 512 * 2;
constexpr size_t WS_HYIN  = WS_MAO + (size_t)DM * DM * 2;
constexpr size_t WS_HYO   = WS_HYIN + (size_t)6144 * DM * 2;
constexpr size_t WS_H     = WS_HYO + (size_t)DM * DM * 2;
constexpr size_t WS_U     = WS_H + (size_t)RA * DM * 4;
constexpr size_t WS_Y     = WS_U + (size_t)RA * DM * 2;
constexpr size_t WS_YP    = WS_Y + (size_t)RA * DM * 2;
constexpr size_t WS_O     = WS_Y + (size_t)RA * DM * 4;
constexpr size_t WS_BIG   = WS_O + (size_t)RA * DM * 2;
constexpr size_t WS_T     = WS_BIG;
constexpr size_t WS_QKV   = WS_BIG;
constexpr size_t WS_Z1    = WS_BIG;
constexpr size_t WS_DC    = WS_Z1 + (size_t)RA * 6400 * 2;
constexpr size_t WS_DN    = WS_DC + (size_t)1088 * 32768 * 4;
constexpr size_t WS_AC    = WS_DN + (size_t)1088 * 128 * 4;
constexpr size_t WS_CS    = WS_AC + 8192;
constexpr size_t WS_NS    = WS_CS + (size_t)1088 * 32768 * 2;
constexpr size_t WS_HD    = WS_NS + (size_t)1088 * 128 * 4;
constexpr size_t WS_GB    = WS_HD + (size_t)2 * RA * DM * 2;
constexpr size_t WS_ML_END = WS_GB + (size_t)1088 * 512 * 4;
constexpr size_t WS_Z2    = WS_BIG;
constexpr size_t WS_ZQ    = WS_Z2 + (size_t)RA * 1280 * 4;
constexpr size_t WS_ZKV   = WS_ZQ + (size_t)RA * 512 * 2;
constexpr size_t WS_KR    = WS_ZKV + (size_t)RA * 512 * 2;
constexpr size_t WS_Q2    = WS_KR + (size_t)RA * 64 * 2;
constexpr size_t WS_KV    = WS_Q2 + (size_t)RL * 3072 * 2;
constexpr size_t WS_ZT    = WS_BIG;
constexpr size_t WS_Y2T   = WS_ZT + (size_t)6144 * RL * 2;
constexpr size_t WS_F     = WS_Y2T + (size_t)DM * RL * 2;
constexpr size_t WS_Y1S   = WS_F + (size_t)8192 * 4096 * 4;
constexpr size_t WS_END   = WS_ML_END;

__device__ __forceinline__ unsigned cvt_pk_bf16(float lo, float hi) { unsigned r; asm volatile("v_cvt_pk_bf16_f32 %0, %1, %2" : "=v"(r) : "v"(lo), "v"(hi)); return r; }
__device__ __forceinline__ bf16_t f2bf(float x) { return (bf16_t)(cvt_pk_bf16(x, 0.f) & 0xffffu); }
__device__ __forceinline__ float bf2f(bf16_t b) { return __uint_as_float(((unsigned)b) << 16); }
__device__ __forceinline__ float bflo(unsigned w) { return __uint_as_float(w << 16); }
__device__ __forceinline__ float bfhi(unsigned w) { return __uint_as_float(w & 0xffff0000u); }
__device__ __forceinline__ int crow(int r, int hi) { return (r & 3) + 8 * (r >> 2) + 4 * hi; }
__device__ __forceinline__ float wave_sum(float v) {
#pragma unroll
    for (int o = 32; o >= 1; o >>= 1) v += __shfl_xor(v, o);
    return v;
}

#define XB_TMO      128
#define XB_XCNT(j)  (256  + 64 * (j))
#define XB_XSUB(j)  (1280 + 64 * (j))
#define XB_XGEN(j)  (2304 + 64 * (j))
#define XB_TOP      3328
#define XB_TOPGEN   3392
#define XCD_BAR_WORDS 3456
#define XB_SPIN_CAP (1u << 18)

__device__ __forceinline__ unsigned xb_ld(unsigned* p)              { return __hip_atomic_load(p, __ATOMIC_RELAXED, __HIP_MEMORY_SCOPE_AGENT); }
__device__ __forceinline__ unsigned xb_add(unsigned* p, unsigned v) { return __hip_atomic_fetch_add(p, v, __ATOMIC_RELAXED, __HIP_MEMORY_SCOPE_AGENT); }
__device__ __forceinline__ unsigned xb_xcc_id() { return (unsigned)__builtin_amdgcn_s_getreg((3 << 11) | 20) & 0xFu; }
#define XB_SPIN(cond, bar) do { unsigned _sp = 0; while (cond) { __builtin_amdgcn_s_sleep(1); \
    if ((++_sp & 255u) == 0u) { if (xb_ld(&(bar)[XB_TMO])) break; if (_sp > XB_SPIN_CAP) { atomicAdd(&(bar)[XB_TMO], 1u); break; } } } } while (0)

struct XcdBarrier {
    unsigned* bar; unsigned x;
    volatile LAS unsigned* st;
};

__device__ __forceinline__ XcdBarrier xcd_barrier_post(unsigned* bar, volatile LAS unsigned* st) {
    XcdBarrier b; b.bar = bar; b.x = xb_xcc_id(); b.st = st;
    if (threadIdx.x == 0) (void)xb_add(&bar[XB_XCNT(b.x)], 1u);
    return b;
}
__device__ __forceinline__ void xcd_barrier_complete(unsigned* bar, unsigned x, unsigned& nloc, unsigned& nx) {
    const unsigned G = gridDim.x * gridDim.y * gridDim.z;
    unsigned sum, cnt, mine, sp = 0u;
    for (;;) {
        sum = 0u; cnt = 0u; mine = 0u;
#pragma unroll
        for (unsigned j = 0; j < 16; ++j) { const unsigned c = xb_ld(&bar[XB_XCNT(j)]); sum += c; cnt += (c > 0u) ? 1u : 0u; mine = (j == x) ? c : mine; }
        if (sum == G) break;
        __builtin_amdgcn_s_sleep(1);
        if ((++sp & 255u) == 0u) { if (xb_ld(&bar[XB_TMO])) break; if (sp > XB_SPIN_CAP) { atomicAdd(&bar[XB_TMO], 1u); break; } }
    }
    nloc = mine > 0u ? mine : 1u; nx = cnt > 0u ? cnt : 1u;
}

__device__ __forceinline__ void xcd_barrier(const XcdBarrier& b) {
    asm volatile("s_waitcnt vmcnt(0)" ::: "memory");
    __syncthreads();
    if (threadIdx.x == 0) {
        unsigned* bar = b.bar;
        __builtin_amdgcn_s_waitcnt(0);
        unsigned nloc = b.st[0], nx = b.st[1];
        if (nloc == 0u) { xcd_barrier_complete(bar, b.x, nloc, nx); b.st[0] = nloc; b.st[1] = nx; }
        const unsigned old = xb_add(&bar[XB_XSUB(b.x)], 1u);
        const unsigned gen = old / nloc;
        if (old + 1u == (gen + 1u) * nloc) {
            __builtin_amdgcn_fence(__ATOMIC_RELEASE, "agent");
            asm volatile("s_waitcnt vmcnt(0)" ::: "memory");
            const unsigned og = xb_add(&bar[XB_TOP], 1u);
            const unsigned tg = og / nx;
            if (og + 1u == (tg + 1u) * nx) xb_add(&bar[XB_TOPGEN], 1u);
            else XB_SPIN(xb_ld(&bar[XB_TOPGEN]) == tg, bar);
            __builtin_amdgcn_fence(__ATOMIC_ACQUIRE, "agent");
            xb_add(&bar[XB_XGEN(b.x)], 1u);
            asm volatile("s_waitcnt vmcnt(0)" ::: "memory");
        } else {
            XB_SPIN(xb_ld(&bar[XB_XGEN(b.x)]) == gen, bar);
            __builtin_amdgcn_fence(__ATOMIC_ACQUIRE, "agent");
            asm volatile("s_waitcnt vmcnt(0)" ::: "memory");
        }
    }
    __syncthreads();
}

namespace pg8 {
#define PG8_LAS __attribute__((address_space(3)))
typedef unsigned short bf16_t;
typedef short bf16x8 __attribute__((ext_vector_type(8)));
typedef float f32x4 __attribute__((ext_vector_type(4)));
typedef unsigned u32x4 __attribute__((ext_vector_type(4)));
constexpr int BM = 256, BK = 64, HALF = 128, HTB = HALF * BK * 2  , STAGE_BYTES = 8 * HTB, NXCD = 8, WGM = 8;

__host__ __device__ __forceinline__ int lds_byte(int r, int c) { const int st = (r >> 4) * 2 + (c >> 5), rr = r & 15, cc = c & 31, ob = rr * 64 + cc * 2; return st * 1024 + (ob ^ (((ob >> 9) & 1) << 5)); }
__host__ __device__ __forceinline__ void stage_rc(int b, int& R, int& C) { const int st = b / 1024, sb = b % 1024, swz = sb ^ (((sb >> 9) & 1) << 5); R = (st >> 1) * 16 + swz / 64; C = (st & 1) * 32 + (swz % 64) / 2; }
__host__ __device__ __forceinline__ int perm32(int rho) { const int n = rho >> 4, i = rho & 15; return 8 * (i >> 2) + 4 * n + (i & 3); }

struct Unit { int pm, pn, ks; };
struct Gemm { const bf16_t* A; const bf16_t* Bt; int M, N, K, ld; };

struct StaticOrder {
    int nM, nN, nwg, G, c, wgm;
    __host__ __device__ void init(int M, int N, int G_, int c_, int wgm_ = WGM) { nM = M / BM; nN = N / BM; nwg = nM * nN; G = G_; c = c_; wgm = wgm_; }
    __host__ __device__ bool next(int i, Unit& u) const {
        const long L = (long)i * G + c; if (L >= nwg) return false;
        int wgid = (int)L; { const int q = nwg / NXCD, r = nwg % NXCD, xcd = wgid % NXCD, off = wgid / NXCD; wgid = (xcd < r ? xcd * (q + 1) : r * (q + 1) + (xcd - r) * q) + off; }
        const int nig = wgm * nN, gid = wgid / nig, fm = gid * wgm, gsz = (nM - fm) < wgm ? (nM - fm) : wgm;
        u.pm = fm + ((wgid % nig) % gsz); u.pn = (wgid % nig) / gsz; u.ks = 0; return true;
    }
    __device__ __forceinline__ void a_ready(const Unit&) const {}
    __device__ __forceinline__ void done(const Unit&) const {}
};
__device__ __forceinline__ unsigned cvt_pk_bf16(float lo, float hi) { unsigned r; asm volatile("v_cvt_pk_bf16_f32 %0, %1, %2" : "=v"(r) : "v"(lo), "v"(hi)); return r; }

template <class Epi, class Sched, bool STAMP = false, int AUXA = 0>
__device__ __forceinline__ void gemm_phase(PG8_LAS unsigned char* lds, const Gemm g, const Sched& S, const Epi& E, unsigned long long* stamps) {
    const int tid = threadIdx.x, wid = __builtin_amdgcn_readfirstlane(tid >> 6), lane = tid & 63, wr = wid >> 2, wc = wid & 3, fr = lane & 15, fq = lane >> 4;
    const int K = g.K, ld = g.ld, nt = K / BK;
    int ts_lo = 0, ts_hi = 0, nts = 0; const unsigned long long rt_entry = STAMP ? (unsigned long long)wall_clock64() : 0ull;
#define PG8_STAMP() do { if (STAMP && wid == 0 && nts < 64) { const unsigned long long _c = (unsigned long long)clock64(); \
        ts_lo = (lane == nts) ? (int)(unsigned)_c : ts_lo; ts_hi = (lane == nts) ? (int)(unsigned)(_c >> 32) : ts_hi; ++nts; } } while (0)
    PG8_STAMP();
    unsigned voffA[2], voffB[2];
#pragma unroll
    for (int i = 0; i < 2; ++i) { int R, C; stage_rc(tid * 16 + i * 8192, R, C); const int Rb = Epi::PERM ? ((R & ~31) + perm32(R & 31)) : R;
        voffA[i] = (unsigned)(R * ld + C) * 2u; voffB[i] = (unsigned)(Rb * ld + C) * 2u; }
    const size_t kstep = (size_t)(BK * 2);
    const size_t hstep = (size_t)HALF * ld * 2;
    const size_t tstep = 2 * hstep;
    const unsigned ldsw = (unsigned)wid * 1024u;
    const int aoff = lds_byte(wr * 64 + fr, fq * 8), boff = lds_byte(wc * 32 + fr, fq * 8);
#define PG8_SA(b, h) (((b) * 2 + (h)) * HTB)
#define PG8_SB(b, h) ((4 + (b) * 2 + (h)) * HTB)
#define PG8_STAGE(bufoff, gbase, voff) do { _Pragma("unroll") for (int _i = 0; _i < 2; ++_i) \
        __builtin_amdgcn_global_load_lds((const unsigned*)((const char*)(gbase) + (voff)[_i]), (PG8_LAS unsigned*)(lds + (bufoff) + ldsw + _i * 8192), 16, 0, 0); } while (0)
#define PG8_STAGEA(bufoff, gbase, voff) do { _Pragma("unroll") for (int _i = 0; _i < 2; ++_i) \
        __builtin_amdgcn_global_load_lds((const unsigned*)((const char*)(gbase) + (voff)[_i]), (PG8_LAS unsigned*)(lds + (bufoff) + ldsw + _i * 8192), 16, 0, AUXA); } while (0)
#define PG8_LDA(dst, b, h) do { _Pragma("unroll") for (int m = 0; m < 4; ++m) _Pragma("unroll") for (int k = 0; k < 2; ++k) dst[m][k] = *(const PG8_LAS bf16x8*)(lds + PG8_SA(b, h) + aoff + m * 2048 + k * 1024); } while (0)
#define PG8_LDB(dst, b, h) do { _Pragma("unroll") for (int n = 0; n < 2; ++n) _Pragma("unroll") for (int k = 0; k < 2; ++k) dst[n][k] = *(const PG8_LAS bf16x8*)(lds + PG8_SB(b, h) + boff + n * 2048 + k * 1024); } while (0)
#define PG8_MMA(ai, bj, At, Bt) do { __builtin_amdgcn_s_setprio(1); _Pragma("unroll") for (int m = 0; m < 4; ++m) _Pragma("unroll") for (int n = 0; n < 2; ++n) _Pragma("unroll") for (int k = 0; k < 2; ++k) \
        acc[ai][bj][m][n] = __builtin_amdgcn_mfma_f32_16x16x32_bf16(Bt[n][k], At[m][k], acc[ai][bj][m][n], 0, 0, 0); __builtin_amdgcn_s_setprio(0); } while (0)
#define PG8_WAIT_V(n) asm volatile("s_waitcnt vmcnt(" #n ")" ::: "memory")
#define PG8_WAIT_L(n) asm volatile("s_waitcnt lgkmcnt(" #n ")" ::: "memory")
#define PG8_BAR __builtin_amdgcn_s_barrier()
#define PG8_SCHED __builtin_amdgcn_sched_barrier(0)
    Unit cur, nxt; int ui = 0;
    if (!S.next(0, cur)) return;
    f32x4 acc[2][2][4][2];
#pragma unroll
    for (int a = 0; a < 2; ++a)
#pragma unroll
        for (int b = 0; b < 2; ++b)
#pragma unroll
            for (int m = 0; m < 4; ++m)
#pragma unroll
                for (int n = 0; n < 2; ++n) acc[a][b][m][n] = (f32x4){0.f, 0.f, 0.f, 0.f};
    bf16x8 At[4][2], B0[2][2], B1[2][2];
    const size_t sstep = (size_t)K * 2;
    const char* cA = (const char*)g.A + (size_t)cur.pm * tstep + (size_t)cur.ks * sstep; const char* cB = (const char*)g.Bt + (size_t)cur.pn * tstep + (size_t)cur.ks * sstep;
    S.a_ready(cur);
    PG8_STAGE(PG8_SB(0, 0), cB, voffB); PG8_STAGEA(PG8_SA(0, 0), cA, voffA); PG8_STAGE(PG8_SB(0, 1), cB + hstep, voffB); PG8_STAGEA(PG8_SA(0, 1), cA + hstep, voffA);
    if (wr == 1) PG8_BAR;
    PG8_WAIT_V(4); PG8_BAR;
    PG8_STAGE(PG8_SB(1, 0), cB + kstep, voffB); PG8_STAGEA(PG8_SA(1, 0), cA + kstep, voffA); PG8_STAGE(PG8_SB(1, 1), cB + hstep + kstep, voffB);
    PG8_WAIT_V(6); PG8_BAR;
    PG8_STAMP();
    for (;;) {
        const bool has_next = S.next(ui + 1, nxt);
        const char* nA = has_next ? (const char*)g.A + (size_t)nxt.pm * tstep + (size_t)nxt.ks * sstep : cA; const char* nB = has_next ? (const char*)g.Bt + (size_t)nxt.pn * tstep + (size_t)nxt.ks * sstep : cB;
        for (int t = 0; t < nt; t += 2) {
            const bool last = (t == nt - 2);
            const char* a1 = cA + (size_t)(t + 1) * kstep;
            const char* a2 = last ? nA : cA + (size_t)(t + 2) * kstep; const char* b2 = last ? nB : cB + (size_t)(t + 2) * kstep;
            const char* a3 = a2 + kstep; const char* b3 = b2 + kstep;
            if (last && has_next) S.a_ready(nxt);
            PG8_LDB(B0, 0, 0); PG8_SCHED; PG8_LDA(At, 0, 0); PG8_STAGEA(PG8_SA(1, 1), a1 + hstep, voffA);
            PG8_WAIT_L(8); PG8_BAR; PG8_WAIT_L(0); PG8_MMA(0, 0, At, B0); PG8_BAR; PG8_SCHED;
            PG8_LDB(B1, 0, 1); PG8_STAGE(PG8_SB(0, 0), b2, voffB);
            PG8_BAR; PG8_WAIT_L(0); PG8_MMA(0, 1, At, B1); PG8_BAR;
            PG8_LDA(At, 0, 1); PG8_STAGEA(PG8_SA(0, 0), a2, voffA);
            PG8_BAR; PG8_WAIT_L(0); PG8_MMA(1, 0, At, B0); PG8_BAR; PG8_SCHED;
            PG8_STAGE(PG8_SB(0, 1), b2 + hstep, voffB);
            PG8_WAIT_V(6); PG8_BAR; PG8_MMA(1, 1, At, B1); PG8_BAR;
            PG8_LDB(B0, 1, 0); PG8_SCHED; PG8_LDA(At, 1, 0); PG8_STAGEA(PG8_SA(0, 1), a2 + hstep, voffA);
            PG8_WAIT_L(8); PG8_BAR; PG8_WAIT_L(0); PG8_MMA(0, 0, At, B0); PG8_BAR; PG8_SCHED;
            PG8_LDB(B1, 1, 1); PG8_STAGE(PG8_SB(1, 0), b3, voffB);
            PG8_BAR; PG8_WAIT_L(0); PG8_MMA(0, 1, At, B1); PG8_BAR;
            PG8_LDA(At, 1, 1); PG8_STAGEA(PG8_SA(1, 0), a3, voffA);
            PG8_BAR; PG8_WAIT_L(0); PG8_MMA(1, 0, At, B0); PG8_BAR; PG8_SCHED;
            PG8_STAGE(PG8_SB(1, 1), b3 + hstep, voffB);
            PG8_WAIT_V(6); PG8_BAR; PG8_MMA(1, 1, At, B1); PG8_BAR;
        }
        PG8_STAMP();
        if constexpr (!Epi::AFTER_DRAIN) { E(acc, cur, wr, wc, fr, fq); S.done(cur); }
        PG8_STAMP();
        if (!has_next) break;
#pragma unroll
        for (int a = 0; a < 2; ++a)
#pragma unroll
            for (int b = 0; b < 2; ++b)
#pragma unroll
                for (int m = 0; m < 4; ++m)
#pragma unroll
                    for (int n = 0; n < 2; ++n) acc[a][b][m][n] = (f32x4){0.f, 0.f, 0.f, 0.f};
        cur = nxt; cA = nA; cB = nB; ++ui;
    }
    PG8_WAIT_V(0);
    if (wr == 0) PG8_BAR;
    PG8_BAR;
    if constexpr (Epi::AFTER_DRAIN) { E.fused(acc, cur, wr, wc, fr, fq, lds, wid, lane); S.done(cur); }
    PG8_STAMP();
    if (STAMP && wid == 0) { stamps[lane] = lane < nts ? (((unsigned long long)(unsigned)ts_hi << 32) | (unsigned)ts_lo) : 0ull;
        if (lane == 62) stamps[62] = rt_entry; if (lane == 63) stamps[63] = (unsigned long long)wall_clock64(); }
#undef PG8_STAMP
#undef PG8_SA
#undef PG8_SB
#undef PG8_STAGE
#undef PG8_STAGEA
#undef PG8_LDA
#undef PG8_LDB
#undef PG8_MMA
#undef PG8_WAIT_V
#undef PG8_WAIT_L
#undef PG8_BAR
#undef PG8_SCHED
}
}

template <int MODE> struct EpiG {
    static constexpr bool PERM = true, AFTER_DRAIN = false;
    void* out; int ldc;
    const f32x2* rope; int head_w, rope_off, rope_cols, tab_stride, rope_rows;
    __device__ __forceinline__ void operator()(const pg8::f32x4 (&acc)[2][2][4][2], const pg8::Unit& u, int wr, int wc, int fr, int fq) const {
        const int row0 = u.pm * 256 + wr * 64 + fr, col0 = u.pn * 256 + wc * 32 + 8 * fq;
#pragma unroll
        for (int ai = 0; ai < 2; ++ai)
#pragma unroll
            for (int m = 0; m < 4; ++m) {
                const int row = row0 + ai * 128 + m * 16;
#pragma unroll
                for (int bj = 0; bj < 2; ++bj) {
                    const int col = col0 + bj * 128;
                    f32x4 v0 = acc[ai][bj][m][0], v1 = acc[ai][bj][m][1];
                    if (MODE == 0) {
                        if (rope != nullptr && col < rope_cols && row < rope_rows) {
                            const int hc = col % head_w;
                            if (hc >= rope_off) {
                                const f32x2* tab = rope + (size_t)(row & 4095) * tab_stride + ((hc - rope_off) >> 1);
                                const f32x2 c0 = tab[0], c1 = tab[1], c2 = tab[2], c3 = tab[3];
                                f32x4 w0, w1;
                                w0[0] = v0[0] * c0.x - v0[1] * c0.y; w0[1] = v0[1] * c0.x + v0[0] * c0.y;
                                w0[2] = v0[2] * c1.x - v0[3] * c1.y; w0[3] = v0[3] * c1.x + v0[2] * c1.y;
                                w1[0] = v1[0] * c2.x - v1[1] * c2.y; w1[1] = v1[1] * c2.x + v1[0] * c2.y;
                                w1[2] = v1[2] * c3.x - v1[3] * c3.y; w1[3] = v1[3] * c3.x + v1[2] * c3.y;
                                v0 = w0; v1 = w1;
                            }
                        }
                    }
                    if (MODE == 1) {
#pragma unroll
                        for (int j = 0; j < 4; ++j) { float a = fmaxf(v0[j], 0.f), b = fmaxf(v1[j], 0.f); v0[j] = a * a; v1[j] = b * b; }
                    }
                    if (MODE == 2) {
                        float* rp = (float*)out + (size_t)row * ldc + col;
                        *(f32x4*)rp = v0; *(f32x4*)(rp + 4) = v1;
                    } else {
                        u32x4 w; w.x = cvt_pk_bf16(v0[0], v0[1]); w.y = cvt_pk_bf16(v0[2], v0[3]); w.z = cvt_pk_bf16(v1[0], v1[1]); w.w = cvt_pk_bf16(v1[2], v1[3]);
                        *(u32x4*)((bf16_t*)out + (size_t)row * ldc + col) = w;
                    }
                }
            }
    }
};
template <int MODE, int AUXA = 0, int WGMV = 8> __device__ __forceinline__ void run_gemm(LAS unsigned char* lds, const bf16_t* A, const bf16_t* Bt, int M, int N, int K, const EpiG<MODE>& E, int vbid) {
    pg8::Gemm g{A, Bt, M, N, K, K};
    pg8::StaticOrder S; S.init(M, N, (int)gridDim.x, vbid, WGMV);
    pg8::gemm_phase<EpiG<MODE>, pg8::StaticOrder, false, AUXA>((PG8_LAS unsigned char*)lds, g, S, E, nullptr);
}
struct SplitOrder {
    int nM, nN, nS, G, c;
    __device__ __forceinline__ bool next(int i, pg8::Unit& u) const {
        const int L = i * G + c; if (L >= nM * nN * nS) return false;
        u.ks = L % nS; const int t = L / nS; u.pn = t % nN; u.pm = t / nN; return true;
    }
    __device__ __forceinline__ void a_ready(const pg8::Unit&) const {}
    __device__ __forceinline__ void done(const pg8::Unit&) const {}
};
struct EpiPart {
    static constexpr bool PERM = true, AFTER_DRAIN = false;
    bf16_t* out; int ldc; size_t split_stride;
    __device__ __forceinline__ void operator()(const pg8::f32x4 (&acc)[2][2][4][2], const pg8::Unit& u, int wr, int wc, int fr, int fq) const {
        const int row0 = u.pm * 256 + wr * 64 + fr, col0 = u.pn * 256 + wc * 32 + 8 * fq;
        bf16_t* base = out + (size_t)u.ks * split_stride;
#pragma unroll
        for (int ai = 0; ai < 2; ++ai)
#pragma unroll
            for (int m = 0; m < 4; ++m)
#pragma unroll
                for (int bj = 0; bj < 2; ++bj) {
                    bf16_t* rp = base + (size_t)(row0 + ai * 128 + m * 16) * ldc + col0 + bj * 128;
                    const f32x4 v0 = acc[ai][bj][m][0], v1 = acc[ai][bj][m][1];
                    u32x4 w; w.x = cvt_pk_bf16(v0[0], v0[1]); w.y = cvt_pk_bf16(v0[2], v0[3]); w.z = cvt_pk_bf16(v1[0], v1[1]); w.w = cvt_pk_bf16(v1[2], v1[3]);
                    *(u32x4*)rp = w;
                }
    }
};
__device__ __forceinline__ void run_gemm_split(LAS unsigned char* lds, const bf16_t* A, const bf16_t* Bt, int M, int N, int Kfull, int nS, bf16_t* P, int vbid) {
    pg8::Gemm g{A, Bt, M, N, Kfull / nS, Kfull};
    SplitOrder S; S.nM = M / 256; S.nN = N / 256; S.nS = nS; S.G = (int)gridDim.x; S.c = vbid;
    EpiPart E; E.out = P; E.ldc = N; E.split_stride = (size_t)M * N;
    pg8::gemm_phase<EpiPart, SplitOrder, false>((PG8_LAS unsigned char*)lds, g, S, E, nullptr);
}
template <int MODE> __device__ __forceinline__ EpiG<MODE> mk_epi(void* out, int ldc) { EpiG<MODE> e; e.out = out; e.ldc = ldc; e.rope = nullptr; e.head_w = 128; e.rope_off = 0; e.rope_cols = 0; e.tab_stride = 0; e.rope_rows = 0; return e; }

struct EpiFilt {
    static constexpr bool PERM = true, AFTER_DRAIN = false;
    bf16_t* F; const float* b4; const float* decay;
    __device__ __forceinline__ void operator()(const pg8::f32x4 (&acc)[2][2][4][2], const pg8::Unit& u, int wr, int wc, int fr, int fq) const {
        const int row0 = u.pm * 256 + wr * 64 + fr, col0 = u.pn * 256 + wc * 32 + 8 * fq;
#pragma unroll
        for (int ai = 0; ai < 2; ++ai)
#pragma unroll
            for (int m = 0; m < 4; ++m) {
                const int row = row0 + ai * 128 + m * 16;
                __builtin_amdgcn_sched_barrier(0);
                const float bb = b4[row], dd = -fabsf(decay[row]) * (1.0f / 4095.0f), st = __expf(dd);
#pragma unroll
                for (int bj = 0; bj < 2; ++bj) {
                    const int l0 = col0 + bj * 128;
                    f32x4 v0 = acc[ai][bj][m][0], v1 = acc[ai][bj][m][1];
                    float w = __expf((float)l0 * dd);
#pragma unroll
                    for (int e = 0; e < 4; ++e) { v0[e] = (v0[e] + bb) * w; w *= st; }
#pragma unroll
                    for (int e = 0; e < 4; ++e) { v1[e] = (v1[e] + bb) * w; w *= st; }
                    u32x4 pk; pk.x = cvt_pk_bf16(v0[0], v0[1]); pk.y = cvt_pk_bf16(v0[2], v0[3]); pk.z = cvt_pk_bf16(v1[0], v1[1]); pk.w = cvt_pk_bf16(v1[2], v1[3]);
                    *(u32x4*)(F + (size_t)row * 4096 + l0) = pk;
                }
            }
    }
};
__device__ __forceinline__ void run_gemm_filt(LAS unsigned char* lds, const bf16_t* W4TB, const bf16_t* A3B, bf16_t* F, const float* b4, const float* decay, int vbid) {
    pg8::Gemm g{W4TB, A3B, 8192, 4096, 256, 256};
    pg8::StaticOrder S; S.init(8192, 4096, (int)gridDim.x, vbid);
    EpiFilt E; E.F = F; E.b4 = b4; E.decay = decay;
    pg8::gemm_phase<EpiFilt, pg8::StaticOrder, false>((PG8_LAS unsigned char*)lds, g, S, E, nullptr);
}

__device__ __forceinline__ int wmap(int kind, int n, int Nsrc) {
    if (kind == 1) {
        if (n < 2560) { const int hb = n & ~127, j = n & 127; return hb + ((j & 1) ? 64 : 0) + (j >> 1); }
        return n;
    }
    if (kind == 2) {
        if (n < 1024) return n;
        if (n < 1088) { const int j = n - 1024; return 1024 + ((j & 1) ? 32 : 0) + (j >> 1); }
        return -1;
    }
    if (kind == 3) {
        const int hd = n / 192, j = n - hd * 192;
        if (j < 128) return n;
        const int jj = j - 128; return hd * 192 + 128 + ((jj & 1) ? 32 : 0) + (jj >> 1);
    }
    return n < Nsrc ? n : -1;
}
__device__ __forceinline__ void conv_weight(LAS unsigned char* lds, const float* __restrict__ src, bf16_t* __restrict__ dst, int K, int Nsrc, int Ndst, int kind, int nscale, float scale, int rank, int nwg) {
    LAS float* tile = (LAS float*)lds;
    const int tid = threadIdx.x, tilesN4 = Ndst / 256, tilesK = K / 64, ngrp = tilesN4 * tilesK;
    const int j = tid & 63, i0 = tid >> 6;
    float v[4][8];
#define CW_LOAD(g_) do { const int tn4_ = (g_) % tilesN4, tk_ = (g_) / tilesN4; \
        _Pragma("unroll") for (int q_ = 0; q_ < 4; ++q_) { const int n_ = tn4_ * 256 + q_ * 64 + j, sc_ = wmap(kind, n_, Nsrc); const float mul_ = (n_ < nscale) ? scale : 1.f; \
            _Pragma("unroll") for (int p_ = 0; p_ < 8; ++p_) v[q_][p_] = (sc_ >= 0) ? __builtin_nontemporal_load(src + (size_t)(tk_ * 64 + p_ * 8 + i0) * Nsrc + sc_) * mul_ : 0.f; } } while (0)
    int g = rank;
    if (g < ngrp) CW_LOAD(g);
    for (; g < ngrp; g += nwg) {
        const int tn4 = g % tilesN4, tk = g / tilesN4;
#pragma unroll
        for (int q = 0; q < 4; ++q)
#pragma unroll
            for (int p = 0; p < 8; ++p) tile[q * 4160 + (p * 8 + i0) * 65 + j] = v[q][p];
        __syncthreads();
        if (g + nwg < ngrp) CW_LOAD(g + nwg);
        {
            const int nn = tid >> 3, kg = tid & 7;
#pragma unroll
            for (int q = 0; q < 4; ++q) {
                float f[8];
#pragma unroll
                for (int e = 0; e < 8; ++e) f[e] = tile[q * 4160 + (kg * 8 + e) * 65 + nn];
                u32x4 w; w.x = cvt_pk_bf16(f[0], f[1]); w.y = cvt_pk_bf16(f[2], f[3]); w.z = cvt_pk_bf16(f[4], f[5]); w.w = cvt_pk_bf16(f[6], f[7]);
                __builtin_nontemporal_store(w, (u32x4*)(dst + (size_t)(tn4 * 256 + q * 64 + nn) * K + tk * 64 + kg * 8));
            }
        }
        __syncthreads();
    }
#undef CW_LOAD
}

__device__ __forceinline__ bool tail_slot(int nunits, int vbid, int& rank, int& n) {
    const int G = (int)gridDim.x, rem = nunits % G;
    if (rem == 0) { rank = vbid; n = G; return true; }
    rank = vbid - rem; n = G - rem; return vbid >= rem;
}

__device__ __forceinline__ float silu_f(float x) { return x / (1.f + __expf(-x)); }

__device__ __forceinline__ void ph_mods(LAS unsigned char* lds, const float* __restrict__ c, const float* __restrict__ c_ctx, const float* __restrict__ ada_w, const float* __restrict__ ada_b, float* __restrict__ mods) {
    LAS float* s = (LAS float*)lds;
    LAS float* red = (LAS float*)(lds + 5 * 2048 * 4);
    const int tid = threadIdx.x;
    for (int i = tid; i < 5 * 2048; i += NTHREADS) { const int m = i >> 11, k = i & 2047; s[i] = silu_f(m < 4 ? c[m * 2048 + k] : c_ctx[k]); }
    __syncthreads();
    const int cq = tid & 15, ks = tid >> 4;
    for (int u = blockIdx.x; u < 4 * 192; u += gridDim.x) {
        const int layer = u / 192, cg = u % 192, col = cg * 64 + cq * 4;
        const float* wp = ada_w + ((size_t)layer * 2048 + ks * 64) * NMOD + col;
        f32x4 a0 = {0.f, 0.f, 0.f, 0.f}, a1 = a0, a2 = a0, a3 = a0, a4 = a0;
#pragma unroll 8
        for (int k = 0; k < 64; ++k) {
            const f32x4 w = __builtin_nontemporal_load((const f32x4*)(wp + (size_t)k * NMOD));
            const int kk = ks * 64 + k;
            a0 += w * s[kk]; a1 += w * s[2048 + kk]; a2 += w * s[4096 + kk]; a3 += w * s[6144 + kk]; a4 += w * s[8192 + kk];
        }
        *(LAS f32x4*)(red + (ks * 5 + 0) * 64 + cq * 4) = a0; *(LAS f32x4*)(red + (ks * 5 + 1) * 64 + cq * 4) = a1; *(LAS f32x4*)(red + (ks * 5 + 2) * 64 + cq * 4) = a2;
        *(LAS f32x4*)(red + (ks * 5 + 3) * 64 + cq * 4) = a3; *(LAS f32x4*)(red + (ks * 5 + 4) * 64 + cq * 4) = a4;
        __syncthreads();
        if (tid < 320) {
            const int m = tid >> 6, cc = tid & 63;
            float vsum = 0.f;
#pragma unroll 8
            for (int q = 0; q < 32; ++q) vsum += red[(q * 5 + m) * 64 + cc];
            mods[((size_t)layer * 5 + m) * NMOD + cg * 64 + cc] = vsum + ada_b[(size_t)layer * NMOD + cg * 64 + cc];
        }
        __syncthreads();
    }
}

__device__ __forceinline__ void ph_tables(f32x2* __restrict__ ropeA, f32x2* __restrict__ ropeC, f32x2* __restrict__ tw) {
    const int gt = blockIdx.x * NTHREADS + threadIdx.x, gn = gridDim.x * NTHREADS;
    for (int i = gt; i < 4096 * 64; i += gn) {
        const int t = i >> 6, p = i & 63, j = p & 31;
        const float inv = powf(10000.0f, -(float)j / 32.0f);
        const float pos = (float)((p < 32) ? (t >> 6) : (t & 63));
        const float ang = pos * inv;
        f32x2 v; v.x = cosf(ang); v.y = sinf(ang); ropeA[i] = v;
    }
    for (int i = gt; i < 4096 * 32; i += gn) {
        const int t = i >> 5, p = i & 31, j = p & 15;
        const float inv = powf(10000.0f, -(float)j / 16.0f);
        const float pos = (float)((p < 16) ? (t >> 6) : (t & 63));
        const float ang = pos * inv;
        f32x2 v; v.x = cosf(ang); v.y = sinf(ang); ropeC[i] = v;
    }
    for (int i = gt; i < 8192; i += gn) {
        float sn, cs; sincospif((float)i / 4096.0f, &sn, &cs);
        f32x2 v; v.x = cs; v.y = -sn; tw[i] = v;
    }
}

__device__ __forceinline__ void ph_hyena_feats(LAS unsigned char* lds, const float* __restrict__ w1, const float* __restrict__ b1, const float* __restrict__ w2, const float* __restrict__ b2,
                                               const float* __restrict__ w3, const float* __restrict__ b3, const float* __restrict__ freq, bf16_t* __restrict__ a3b) {
    const int tid = threadIdx.x, wave = tid >> 6, lane = tid & 63;
    LAS float* fa = (LAS float*)lds + wave * 128;
    LAS float* fb = fa + 64;
    const float fr = freq[lane];
    for (int l0 = blockIdx.x * 8; l0 < 4096; l0 += gridDim.x * 8) {
        const int l = l0 + wave;
        const float w = (6.283185307179586f / 4096.0f) * (float)l;
        float f = 0.f;
        if (lane == 0) f = (float)l * (1.0f / 4095.0f);
        else if (lane <= 32) {
            const int j = (lane - 1) & 15;
            const float band = 1e-4f + (float)j * ((15.0f - 1e-4f) / 15.0f);
            f = (lane <= 16) ? cosf(band * w) : -sinf(band * w);
        }
        __syncthreads();
        fa[lane] = f;
        __syncthreads();
        float acc = b1[lane];
        for (int i = 0; i < 33; ++i) acc += fa[i] * w1[i * 64 + lane];
        fb[lane] = sinf(fr * acc);
        __syncthreads();
        acc = b2[lane];
        for (int i = 0; i < 64; ++i) acc += fb[i] * w2[i * 64 + lane];
        fa[lane] = sinf(fr * acc);
        __syncthreads();
        acc = b3[lane];
        for (int i = 0; i < 64; ++i) acc += fa[i] * w3[i * 64 + lane];
        a3b[(size_t)l * 256 + lane] = f2bf(sinf(fr * acc));
        a3b[(size_t)l * 256 + 64 + lane] = 0; a3b[(size_t)l * 256 + 128 + lane] = 0; a3b[(size_t)l * 256 + 192 + lane] = 0;
    }
}

__device__ __forceinline__ void conv_w4(const float* __restrict__ w4, bf16_t* __restrict__ w4tb) {
    const int gt = blockIdx.x * NTHREADS + threadIdx.x, gn = gridDim.x * NTHREADS;
    for (int idx = gt; idx < 32 * 8192; idx += gn) {
        const int kg = idx >> 13, col = idx & 8191;
        u32x4 w = {0u, 0u, 0u, 0u};
        if (kg < 8) {
            float f[8];
#pragma unroll
            for (int q = 0; q < 8; ++q) f[q] = w4[(size_t)(kg * 8 + q) * 8192 + col];
            w.x = cvt_pk_bf16(f[0], f[1]); w.y = cvt_pk_bf16(f[2], f[3]); w.z = cvt_pk_bf16(f[4], f[5]); w.w = cvt_pk_bf16(f[6], f[7]);
        }
        *(u32x4*)(w4tb + (size_t)col * 256 + kg * 8) = w;
    }
}

__device__ __forceinline__ void ph_normmod(const float* __restrict__ xin, const float* __restrict__ cin, const float* __restrict__ h, bool from_input,
                                           const float* __restrict__ g, const float* __restrict__ mods, int kshift, int kscale, bf16_t* __restrict__ out, int nrows) {
    const int lane = threadIdx.x & 63, gw = blockIdx.x * NWAVES + (threadIdx.x >> 6), nw = gridDim.x * NWAVES;
    f32x4 vn[8];
#define NM_LOAD(r_) do { const int rr_ = (r_); const float* src_ = from_input ? (rr_ < RL ? xin + (size_t)rr_ * DM : cin + (size_t)(rr_ - RL) * DM) : h + (size_t)rr_ * DM; \
        _Pragma("unroll") for (int j_ = 0; j_ < 8; ++j_) vn[j_] = __builtin_nontemporal_load((const f32x4*)(src_ + j_ * 256 + lane * 4)); } while (0)
    if (gw < nrows) NM_LOAD(gw);
    for (int r = gw; r < nrows; r += nw) {
        const int b = r < RL ? (r >> 12) : 4;
        const float* sh = mods + (size_t)b * NMOD + kshift * DM;
        const float* sc = mods + (size_t)b * NMOD + kscale * DM;
        f32x4 v[8]; float ss = 0.f;
#pragma unroll
        for (int j = 0; j < 8; ++j) { v[j] = vn[j]; ss += v[j][0] * v[j][0] + v[j][1] * v[j][1] + v[j][2] * v[j][2] + v[j][3] * v[j][3]; }
        if (r + nw < nrows) NM_LOAD(r + nw);
        ss = wave_sum(ss);
        const float rstd = rsqrtf(ss * (1.0f / DM) + RMS_EPS);
#pragma unroll
        for (int j = 0; j < 8; ++j) {
            const int col = j * 256 + lane * 4;
            const f32x4 gg = *(const f32x4*)(g + col), s1 = *(const f32x4*)(sh + col), s2 = *(const f32x4*)(sc + col);
            f32x4 o;
#pragma unroll
            for (int e = 0; e < 4; ++e) o[e] = (v[j][e] * rstd * gg[e]) * (1.f + s2[e]) + s1[e];
            u32x2 w; w.x = cvt_pk_bf16(o[0], o[1]); w.y = cvt_pk_bf16(o[2], o[3]);
            *(u32x2*)(out + (size_t)r * DM + col) = w;
        }
    }
#undef NM_LOAD
}

struct RsRow { u32x2 y[8]; f32x4 h[8]; u32x2 hb[8]; };
template <bool HIN_F32>
__device__ __forceinline__ void rs_load(RsRow& R, int rr, int lane, const bf16_t* __restrict__ y, const bf16_t* __restrict__ ypart,
                                        const float* __restrict__ xin, const float* __restrict__ cin, const bf16_t* __restrict__ h) {
    if (HIN_F32) {
        const float* src = rr < RL ? xin + (size_t)rr * DM : cin + (size_t)(rr - RL) * DM;
#pragma unroll
        for (int j = 0; j < 8; ++j) R.h[j] = __builtin_nontemporal_load((const f32x4*)(src + j * 256 + lane * 4));
    } else {
#pragma unroll
        for (int j = 0; j < 8; ++j) R.hb[j] = __builtin_nontemporal_load((const u32x2*)(h + (size_t)rr * DM + j * 256 + lane * 4));
    }
    if (ypart != nullptr && rr >= RL) {
#pragma unroll
        for (int j = 0; j < 8; ++j) {
            const bf16_t* pp = ypart + (size_t)(rr - RL) * DM + j * 256 + lane * 4; f32x4 a = {0.f, 0.f, 0.f, 0.f};
#pragma unroll
            for (int q = 0; q < 8; ++q) { const u32x2 pv = *(const u32x2*)(pp + (size_t)q * (NB * CTX) * DM); a[0] += bflo(pv.x); a[1] += bfhi(pv.x); a[2] += bflo(pv.y); a[3] += bfhi(pv.y); }
            R.y[j].x = cvt_pk_bf16(a[0], a[1]); R.y[j].y = cvt_pk_bf16(a[2], a[3]);
        }
    } else {
#pragma unroll
        for (int j = 0; j < 8; ++j) R.y[j] = __builtin_nontemporal_load((const u32x2*)(y + (size_t)rr * DM + j * 256 + lane * 4));
    }
}
template <bool HIN_F32, bool HOUT_F32>
__device__ __forceinline__ void rs_consume(const RsRow& R, int r, int lane, const LAS float* P, void* __restrict__ hdst, bool do_norm, bf16_t* __restrict__ uout) {
    const int b = r < RL ? (r >> 12) : 4;
    const LAS float* gt = P + (2 + 3 * b) * DM;
    f32x4 v[8]; float ss = 0.f;
#pragma unroll
    for (int j = 0; j < 8; ++j) {
        v[j][0] = bflo(R.y[j].x); v[j][1] = bfhi(R.y[j].x); v[j][2] = bflo(R.y[j].y); v[j][3] = bfhi(R.y[j].y);
        ss += v[j][0] * v[j][0] + v[j][1] * v[j][1] + v[j][2] * v[j][2] + v[j][3] * v[j][3];
    }
    ss = wave_sum(ss);
    const float rstd = rsqrtf(ss * (1.0f / DM) + RMS_EPS);
    float ss2 = 0.f;
#pragma unroll
    for (int j = 0; j < 8; ++j) {
        const int col = j * 256 + lane * 4;
        const f32x4 gg = *(const LAS f32x4*)(P + col), ga = *(const LAS f32x4*)(gt + col);
        f32x4 hv;
        if (HIN_F32) hv = R.h[j];
        else { hv[0] = bflo(R.hb[j].x); hv[1] = bfhi(R.hb[j].x); hv[2] = bflo(R.hb[j].y); hv[3] = bfhi(R.hb[j].y); }
        f32x4 o;
#pragma unroll
        for (int e = 0; e < 4; ++e) { o[e] = hv[e] + ga[e] * (v[j][e] * rstd * gg[e]); ss2 += o[e] * o[e]; }
        if (HOUT_F32) __builtin_nontemporal_store(o, (f32x4*)((float*)hdst + (size_t)r * DM + col));
        else { u32x2 w; w.x = cvt_pk_bf16(o[0], o[1]); w.y = cvt_pk_bf16(o[2], o[3]); __builtin_nontemporal_store(w, (u32x2*)((bf16_t*)hdst + (size_t)r * DM + col)); }
        v[j] = o;
    }
    if (do_norm) {
        ss2 = wave_sum(ss2);
        const float rstd2 = rsqrtf(ss2 * (1.0f / DM) + RMS_EPS);
#pragma unroll
        for (int j = 0; j < 8; ++j) {
            const int col = j * 256 + lane * 4;
            const f32x4 gg = *(const LAS f32x4*)(P + DM + col), s1 = *(const LAS f32x4*)(gt + DM + col), s2 = *(const LAS f32x4*)(gt + 2 * DM + col);
            f32x4 o;
#pragma unroll
            for (int e = 0; e < 4; ++e) o[e] = (v[j][e] * rstd2 * gg[e]) * (1.f + s2[e]) + s1[e];
            u32x2 w; w.x = cvt_pk_bf16(o[0], o[1]); w.y = cvt_pk_bf16(o[2], o[3]);
            *(u32x2*)(uout + (size_t)r * DM + col) = w;
        }
    }
}
template <bool HIN_F32, bool HOUT_F32>
__device__ __forceinline__ void ph_resid(LAS unsigned char* lds, const bf16_t* __restrict__ y, const bf16_t* __restrict__ ypart, const float* __restrict__ gy, const float* __restrict__ mods, int kgate,
                                         const float* __restrict__ xin, const float* __restrict__ cin, const bf16_t* __restrict__ h,
                                         void* __restrict__ hdst, bool do_norm, const float* __restrict__ g2, const float* __restrict__ mods2, int kshift, int kscale,
                                         bf16_t* __restrict__ uout, int nrows) {
    const int lane = threadIdx.x & 63, gw = blockIdx.x * NWAVES + (threadIdx.x >> 6), nw = gridDim.x * NWAVES;
    LAS float* P = (LAS float*)lds;
    RsRow A, B;
    if (gw < nrows) rs_load<HIN_F32>(A, gw, lane, y, ypart, xin, cin, h);
    if (gw + nw < nrows) rs_load<HIN_F32>(B, gw + nw, lane, y, ypart, xin, cin, h);
    __syncthreads();
    for (int i = threadIdx.x; i < 17 * (DM / 4); i += NTHREADS) {
        const int vsel = i / (DM / 4), c4 = (i % (DM / 4)) * 4;
        f32x4 val = {0.f, 0.f, 0.f, 0.f};
        if (vsel == 0) val = *(const f32x4*)(gy + c4);
        else if (vsel == 1) { if (do_norm) val = *(const f32x4*)(g2 + c4); }
        else { const int bb = (vsel - 2) / 3, kk = (vsel - 2) % 3;
               if (kk == 0) val = *(const f32x4*)(mods + (size_t)bb * NMOD + kgate * DM + c4);
               else if (do_norm) val = *(const f32x4*)(mods2 + (size_t)bb * NMOD + (kk == 1 ? kshift : kscale) * DM + c4); }
        *(LAS f32x4*)(P + vsel * DM + c4) = val;
    }
    __syncthreads();
#pragma unroll 1
    for (int r = gw; r < nrows; r += 2 * nw) {
        rs_consume<HIN_F32, HOUT_F32>(A, r, lane, P, hdst, do_norm, uout);
        if (r + 2 * nw < nrows) rs_load<HIN_F32>(A, r + 2 * nw, lane, y, ypart, xin, cin, h);
        if (r + nw < nrows) {
            rs_consume<HIN_F32, HOUT_F32>(B, r + nw, lane, P, hdst, do_norm, uout);
            if (r + 3 * nw < nrows) rs_load<HIN_F32>(B, r + 3 * nw, lane, y, ypart, xin, cin, h);
        }
    }
}

__device__ __forceinline__ void ph_mla_rows(const bf16_t* __restrict__ z, const float* __restrict__ qg, const float* __restrict__ kvg, const f32x2* __restrict__ ropeC,
                                            bf16_t* __restrict__ zq, bf16_t* __restrict__ zkv, bf16_t* __restrict__ kr) {
    const int lane = threadIdx.x & 63, gw = blockIdx.x * NWAVES + (threadIdx.x >> 6), nw = gridDim.x * NWAVES;
    u32x2 zn[4]; bf16_t xn = 0;
#define MR_LOAD(r_) do { const bf16_t* zr_ = z + (size_t)(r_) * 1280; \
        _Pragma("unroll") for (int q_ = 0; q_ < 4; ++q_) zn[q_] = __builtin_nontemporal_load((const u32x2*)(zr_ + q_ * 256 + lane * 4)); xn = zr_[1024 + lane]; } while (0)
    if (gw < RA) MR_LOAD(gw);
    for (int r = gw; r < RA; r += nw) {
        f32x4 zc[4];
#pragma unroll
        for (int q = 0; q < 4; ++q) { zc[q][0] = bflo(zn[q].x); zc[q][1] = bfhi(zn[q].x); zc[q][2] = bflo(zn[q].y); zc[q][3] = bfhi(zn[q].y); }
        const float x = bf2f(xn);
        if (r + nw < RA) MR_LOAD(r + nw);
#pragma unroll
        for (int part = 0; part < 2; ++part) {
            const f32x4 a = zc[2 * part], b = zc[2 * part + 1];
            float ss = a[0] * a[0] + a[1] * a[1] + a[2] * a[2] + a[3] * a[3] + b[0] * b[0] + b[1] * b[1] + b[2] * b[2] + b[3] * b[3];
            ss = wave_sum(ss);
            const float rstd = rsqrtf(ss * (1.0f / 512.0f) + RMS_EPS);
            const float* gp = (part ? kvg : qg) + lane * 4;
            const f32x4 g0 = *(const f32x4*)gp, g1 = *(const f32x4*)(gp + 256);
            u32x2 w0, w1;
            w0.x = cvt_pk_bf16(a[0] * rstd * g0[0], a[1] * rstd * g0[1]); w0.y = cvt_pk_bf16(a[2] * rstd * g0[2], a[3] * rstd * g0[3]);
            w1.x = cvt_pk_bf16(b[0] * rstd * g1[0], b[1] * rstd * g1[1]); w1.y = cvt_pk_bf16(b[2] * rstd * g1[2], b[3] * rstd * g1[3]);
            bf16_t* op = (part ? zkv : zq) + (size_t)r * 512 + lane * 4;
            *(u32x2*)op = w0; *(u32x2*)(op + 256) = w1;
        }
        const float xp = __shfl_xor(x, 1);
        float o = x;
        if (r < RL) {
            const f32x2 cs = ropeC[(size_t)(r & 4095) * 32 + (lane >> 1)];
            o = (lane & 1) ? (x * cs.x + xp * cs.y) : (x * cs.x - xp * cs.y);
        }
        kr[(size_t)r * 64 + lane] = f2bf(o);
    }
#undef MR_LOAD
}

__device__ __forceinline__ void ph_headnorm(const bf16_t* __restrict__ hf, const bf16_t* __restrict__ hb, const bf16_t* __restrict__ z1, const float* __restrict__ head_g, bf16_t* __restrict__ out) {
    const int lane = threadIdx.x & 63, gw = blockIdx.x * NWAVES + (threadIdx.x >> 6), nw = gridDim.x * NWAVES;
    u32x4 an[4], bn[4], gn[4];
#define HN_LOAD(r_) do { const size_t ro_ = (size_t)(r_) * DM + lane * 8, rz_ = (size_t)(r_) * 6400 + 4096 + lane * 8; \
        _Pragma("unroll") for (int q_ = 0; q_ < 4; ++q_) { an[q_] = __builtin_nontemporal_load((const u32x4*)(hf + ro_ + q_ * 512)); bn[q_] = __builtin_nontemporal_load((const u32x4*)(hb + ro_ + q_ * 512)); \
            gn[q_] = __builtin_nontemporal_load((const u32x4*)(z1 + rz_ + q_ * 512)); } } while (0)
    if (gw < RA) HN_LOAD(gw);
    for (int r = gw; r < RA; r += nw) {
        float v[32]; float ss[4]; u32x4 og[4];
#pragma unroll
        for (int q = 0; q < 4; ++q) {
            const u32x4 a = an[q], b = bn[q]; og[q] = gn[q]; float t = 0.f;
#pragma unroll
            for (int e = 0; e < 4; ++e) { const float x0 = bflo(a[e]) + bflo(b[e]), x1 = bfhi(a[e]) + bfhi(b[e]); v[q * 8 + 2 * e] = x0; v[q * 8 + 2 * e + 1] = x1; t += x0 * x0 + x1 * x1; }
            ss[q] = t;
        }
        if (r + nw < RA) HN_LOAD(r + nw);
#pragma unroll
        for (int q = 0; q < 4; ++q) {
            float t = ss[q];
            t += __shfl_xor(t, 1); t += __shfl_xor(t, 2); t += __shfl_xor(t, 4); t += __shfl_xor(t, 8); t += __shfl_xor(t, 16);
            const float rstd = rsqrtf(t * (1.0f / 256.0f) + RMS_EPS);
            const f32x4 g0 = *(const f32x4*)(head_g + q * 512 + lane * 8), g1 = *(const f32x4*)(head_g + q * 512 + lane * 8 + 4);
            float o[8];
#pragma unroll
            for (int e = 0; e < 4; ++e) {
                const float ga = 1.f / (1.f + __expf(-bflo(og[q][e]))), gb = 1.f / (1.f + __expf(-bfhi(og[q][e])));
                const float gg0 = (e < 2) ? g0[2 * e] : g1[2 * e - 4], gg1 = (e < 2) ? g0[2 * e + 1] : g1[2 * e - 3];
                o[2 * e] = v[q * 8 + 2 * e] * rstd * gg0 * ga; o[2 * e + 1] = v[q * 8 + 2 * e + 1] * rstd * gg1 * gb;
            }
            u32x4 w; w.x = cvt_pk_bf16(o[0], o[1]); w.y = cvt_pk_bf16(o[2], o[3]); w.z = cvt_pk_bf16(o[4], o[5]); w.w = cvt_pk_bf16(o[6], o[7]);
            *(u32x4*)(out + (size_t)r * DM + q * 512 + lane * 8) = w;
        }
    }
#undef HN_LOAD
}

__device__ __forceinline__ void ph_transpose(LAS unsigned char* lds, const bf16_t* __restrict__ src, bf16_t* __restrict__ dst) {
    LAS bf16_t* tile = (LAS bf16_t*)lds;
    const int tid = threadIdx.x;
    const int ntile = (DM / 64) * (RL / 64);
    const int c = tid >> 3, ch = tid & 7;
    u32x4 wn = {0u, 0u, 0u, 0u};
    int t = blockIdx.x;
    if (t < ntile) { const int tc = t % (DM / 64), tr = t / (DM / 64); wn = __builtin_nontemporal_load((const u32x4*)(src + (size_t)(tc * 64 + c) * RL + tr * 64 + ch * 8)); }
    for (; t < ntile; t += gridDim.x) {
        const int tc = t % (DM / 64), tr = t / (DM / 64);
        *(LAS u32x4*)(tile + c * 72 + ch * 8) = wn;
        __syncthreads();
        const int t2 = t + gridDim.x;
        if (t2 < ntile) { const int tc2 = t2 % (DM / 64), tr2 = t2 / (DM / 64); wn = __builtin_nontemporal_load((const u32x4*)(src + (size_t)(tc2 * 64 + c) * RL + tr2 * 64 + ch * 8)); }
        {
            bf16_t e[8];
#pragma unroll
            for (int q = 0; q < 8; ++q) e[q] = tile[(ch * 8 + q) * 72 + c];
            u32x4 w; w.x = e[0] | ((unsigned)e[1] << 16); w.y = e[2] | ((unsigned)e[3] << 16); w.z = e[4] | ((unsigned)e[5] << 16); w.w = e[6] | ((unsigned)e[7] << 16);
            *(u32x4*)(dst + (size_t)(tr * 64 + c) * DM + tc * 64 + ch * 8) = w;
        }
        __syncthreads();
    }
}

template <int OFF> __device__ __forceinline__ s16x4 tr_read(unsigned addr) {
    s16x4 r; asm volatile("ds_read_b64_tr_b16 %0, %1 offset:%2" : "=&v"(r) : "v"(addr), "i"(OFF) : "memory"); return r;
}
#define MFMA32(a, b, c) __builtin_amdgcn_mfma_f32_32x32x16_bf16((a), (b), (c), 0, 0, 0)
#define PK8(L, H) ((bf16x8){L[0], L[1], L[2], L[3], H[0], H[1], H[2], H[3]})

constexpr int VSTR = 320;
template <int DQK> struct AttnGeo {
    static constexpr int KSTR = DQK * 2 + 16;
    static constexpr int KBUF = 64 * KSTR, VBUF = 64 * VSTR;
    static constexpr int VOFF = 2 * KBUF, TOTAL = 2 * KBUF + 2 * VBUF;
    static constexpr int KCH = DQK / 8;
    static constexpr int NKL = (64 * KCH) / NTHREADS;
};

template <int C> __device__ __forceinline__ void pv_block(f32x16& oc, unsigned vaddr, const bf16x8 (&pf)[4]) {
    const s16x4 l0 = tr_read<(0 * 16 + 0) * VSTR + C * 64>(vaddr), h0 = tr_read<(0 * 16 + 8) * VSTR + C * 64>(vaddr);
    const s16x4 l1 = tr_read<(1 * 16 + 0) * VSTR + C * 64>(vaddr), h1 = tr_read<(1 * 16 + 8) * VSTR + C * 64>(vaddr);
    const s16x4 l2 = tr_read<(2 * 16 + 0) * VSTR + C * 64>(vaddr), h2 = tr_read<(2 * 16 + 8) * VSTR + C * 64>(vaddr);
    const s16x4 l3 = tr_read<(3 * 16 + 0) * VSTR + C * 64>(vaddr), h3 = tr_read<(3 * 16 + 8) * VSTR + C * 64>(vaddr);
    asm volatile("s_waitcnt lgkmcnt(0)" ::: "memory"); __builtin_amdgcn_sched_barrier(0);
    oc = MFMA32(PK8(l0, h0), pf[0], oc);
    oc = MFMA32(PK8(l1, h1), pf[1], oc);
    oc = MFMA32(PK8(l2, h2), pf[2], oc);
    oc = MFMA32(PK8(l3, h3), pf[3], oc);
}

template <int C0, int C1> __device__ __forceinline__ void pv_block2(f32x16& oa, f32x16& ob, unsigned vaddr, const bf16x8 (&pf)[4]) {
    const s16x4 al0 = tr_read<(0 * 16 + 0) * VSTR + C0 * 64>(vaddr), ah0 = tr_read<(0 * 16 + 8) * VSTR + C0 * 64>(vaddr);
    const s16x4 bl0 = tr_read<(0 * 16 + 0) * VSTR + C1 * 64>(vaddr), bh0 = tr_read<(0 * 16 + 8) * VSTR + C1 * 64>(vaddr);
    const s16x4 al1 = tr_read<(1 * 16 + 0) * VSTR + C0 * 64>(vaddr), ah1 = tr_read<(1 * 16 + 8) * VSTR + C0 * 64>(vaddr);
    const s16x4 bl1 = tr_read<(1 * 16 + 0) * VSTR + C1 * 64>(vaddr), bh1 = tr_read<(1 * 16 + 8) * VSTR + C1 * 64>(vaddr);
    const s16x4 al2 = tr_read<(2 * 16 + 0) * VSTR + C0 * 64>(vaddr), ah2 = tr_read<(2 * 16 + 8) * VSTR + C0 * 64>(vaddr);
    const s16x4 bl2 = tr_read<(2 * 16 + 0) * VSTR + C1 * 64>(vaddr), bh2 = tr_read<(2 * 16 + 8) * VSTR + C1 * 64>(vaddr);
    const s16x4 al3 = tr_read<(3 * 16 + 0) * VSTR + C0 * 64>(vaddr), ah3 = tr_read<(3 * 16 + 8) * VSTR + C0 * 64>(vaddr);
    const s16x4 bl3 = tr_read<(3 * 16 + 0) * VSTR + C1 * 64>(vaddr), bh3 = tr_read<(3 * 16 + 8) * VSTR + C1 * 64>(vaddr);
    asm volatile("s_waitcnt lgkmcnt(0)" ::: "memory"); __builtin_amdgcn_sched_barrier(0);
    oa = MFMA32(PK8(al0, ah0), pf[0], oa); ob = MFMA32(PK8(bl0, bh0), pf[0], ob);
    oa = MFMA32(PK8(al1, ah1), pf[1], oa); ob = MFMA32(PK8(bl1, bh1), pf[1], ob);
    oa = MFMA32(PK8(al2, ah2), pf[2], oa); ob = MFMA32(PK8(bl2, bh2), pf[2], ob);
    oa = MFMA32(PK8(al3, ah3), pf[3], oa); ob = MFMA32(PK8(bl3, bh3), pf[3], ob);
}

__device__ __forceinline__ void store_tile_32x128(LAS unsigned char* stage, const f32x16 (&o)[4], float inv, bf16_t* __restrict__ orow0, int opitch, int lane) {
    const int r32 = lane & 31, hi = lane >> 5;
    LAS unsigned char* wr = stage + r32 * 272 + hi * 8;
#pragma unroll
    for (int c = 0; c < 4; ++c)
#pragma unroll
        for (int g = 0; g < 4; ++g) {
            u32x2 w; w.x = cvt_pk_bf16(o[c][4 * g] * inv, o[c][4 * g + 1] * inv); w.y = cvt_pk_bf16(o[c][4 * g + 2] * inv, o[c][4 * g + 3] * inv);
            *(LAS u32x2*)(wr + c * 64 + g * 16) = w;
        }
    __builtin_amdgcn_sched_barrier(0);
#pragma unroll 2
    for (int i = 0; i < 8; ++i) {
        const int id = lane + 64 * i, rr = id >> 4, cc = id & 15;
        const u32x4 v = *(const LAS u32x4*)(stage + rr * 272 + cc * 16);
        *(u32x4*)(orow0 + (size_t)rr * opitch + cc * 8) = v;
    }
}

template <int DQK>
__device__ __forceinline__ void attn_unit(LAS unsigned char* lds, const bf16_t* __restrict__ qp, int qpitch,
                                          const bf16_t* __restrict__ kb, int kpitch, const bf16_t* __restrict__ krb, const bf16_t* __restrict__ vb, int vpitch,
                                          int row0, int nt0, int row1, int nt1, bool masked, int kpos0, int qpos0,
                                          float sc_l2, bool has_sink, float sink_l2, bf16_t* __restrict__ op, int opitch, bool gqa = false, const float* __restrict__ sink4 = nullptr) {
    typedef AttnGeo<DQK> G;
    const int tid = threadIdx.x, wave = tid >> 6, lane = tid & 63, r32 = lane & 31, hi = lane >> 5;
    const int NT = nt0 + nt1;
    const int wrow = gqa ? (wave & 1) * 32 : wave * 32, whead = gqa ? (wave >> 1) * 128 : 0;
    if (gqa) sink_l2 = sink4[wave >> 1] * 1.4426950408889634f;
    bf16x8 qf[DQK / 16];
    {
        const bf16_t* qrow = qp + (size_t)(wrow + r32) * qpitch + whead + hi * 8;
#pragma unroll
        for (int j = 0; j < DQK / 16; ++j) qf[j] = *(const bf16x8*)(qrow + j * 16);
    }
    u32x4 kreg[G::NKL], vreg[2];
    auto tile_row = [&](int t) -> int { return t < nt0 ? row0 + 64 * t : row1 + 64 * (t - nt0); };
#define ATT_LOAD(t) do { const int rb_ = tile_row(t); \
        _Pragma("unroll") for (int i_ = 0; i_ < G::NKL; ++i_) { const int id_ = tid + i_ * NTHREADS, rr_ = id_ / G::KCH, cc_ = id_ % G::KCH; \
            kreg[i_] = (cc_ < 16) ? *(const u32x4*)(kb + (size_t)(rb_ + rr_) * kpitch + cc_ * 8) : *(const u32x4*)(krb + (size_t)(rb_ + rr_) * 64 + (cc_ - 16) * 8); } \
        _Pragma("unroll") for (int i_ = 0; i_ < 2; ++i_) { const int id_ = tid + i_ * NTHREADS, rr_ = id_ >> 4, cc_ = id_ & 15; \
            vreg[i_] = *(const u32x4*)(vb + (size_t)(rb_ + rr_) * vpitch + cc_ * 8); } } while (0)
#define ATT_WRITE(buf) do { \
        _Pragma("unroll") for (int i_ = 0; i_ < G::NKL; ++i_) { const int id_ = tid + i_ * NTHREADS, rr_ = id_ / G::KCH, cc_ = id_ % G::KCH; \
            *(LAS u32x4*)(lds + (buf) * G::KBUF + rr_ * G::KSTR + cc_ * 16) = kreg[i_]; } \
        _Pragma("unroll") for (int i_ = 0; i_ < 2; ++i_) { const int id_ = tid + i_ * NTHREADS, rr_ = id_ >> 4, cc_ = id_ & 15; \
            *(LAS u32x4*)(lds + G::VOFF + (buf) * G::VBUF + rr_ * VSTR + cc_ * 16) = vreg[i_]; } } while (0)

    float m = has_sink ? sink_l2 : -1e30f;
    float l = (has_sink && hi == 0) ? 1.f : 0.f;
    f32x16 o[4];
#pragma unroll
    for (int c = 0; c < 4; ++c)
#pragma unroll
        for (int r = 0; r < 16; ++r) o[c][r] = 0.f;
    const int qpos = qpos0 + wrow + r32;
    const unsigned vlane = (unsigned)(size_t)(lds + G::VOFF) + (unsigned)((4 * hi + ((lane & 15) >> 2)) * VSTR + ((lane >> 4) & 1) * 32 + (lane & 3) * 8);

    __syncthreads();
    ATT_LOAD(0); ATT_WRITE(0);
    __syncthreads();
    for (int t = 0; t < NT; ++t) {
        const int buf = t & 1;
        if (t + 1 < NT) ATT_LOAD(t + 1);
        const int kt0_ = kpos0 + 64 * t, ql_ = qpos0 + wrow;
        const bool live = !(masked && t < nt0) || ((kt0_ + 63 >= ql_ - 128) && (kt0_ <= ql_ + 31 + 128));
        if (live) {
        f32x16 s0, s1;
#pragma unroll
        for (int r = 0; r < 16; ++r) { s0[r] = 0.f; s1[r] = 0.f; }
        {
            const LAS unsigned char* kbuf = lds + buf * G::KBUF + r32 * G::KSTR + hi * 16;
#pragma unroll
            for (int j = 0; j < DQK / 16; ++j) {
                const bf16x8 a0 = *(const LAS bf16x8*)(kbuf + j * 32);
                const bf16x8 a1 = *(const LAS bf16x8*)(kbuf + 32 * G::KSTR + j * 32);
                s0 = MFMA32(a0, qf[j], s0);
                s1 = MFMA32(a1, qf[j], s1);
            }
        }
        const bool mt = masked && (t < nt0);
        const int kp0 = kpos0 + 64 * t - qpos;
        float mx = -1e30f;
#pragma unroll
        for (int r = 0; r < 16; ++r) {
            float x0 = s0[r], x1 = s1[r];
            if (mt) { const int d0 = kp0 + crow(r, hi), d1 = d0 + 32; if (d0 > 128 || d0 < -128) x0 = -1e30f; if (d1 > 128 || d1 < -128) x1 = -1e30f; }
            s0[r] = x0; s1[r] = x1; mx = fmaxf(mx, fmaxf(x0, x1));
        }
        mx = fmaxf(mx, __shfl_xor(mx, 32));
        const float mn = fmaxf(m, mx * sc_l2);
        const float alpha = __builtin_amdgcn_exp2f(m - mn);
        m = mn;
        float ps = 0.f;
#pragma unroll
        for (int r = 0; r < 16; ++r) { const float p0 = __builtin_amdgcn_exp2f(__builtin_fmaf(s0[r], sc_l2, -mn)), p1 = __builtin_amdgcn_exp2f(__builtin_fmaf(s1[r], sc_l2, -mn)); s0[r] = p0; s1[r] = p1; ps += p0 + p1; }
        l = l * alpha + ps;
        if (DQK != 192 || __any(alpha < 1.f)) {
#pragma unroll
            for (int c = 0; c < 4; ++c)
#pragma unroll
                for (int r = 0; r < 16; ++r) o[c][r] *= alpha;
        }
        bf16x8 pf[4];
        {
            u32x4 w;
            w.x = cvt_pk_bf16(s0[0], s0[1]); w.y = cvt_pk_bf16(s0[2], s0[3]); w.z = cvt_pk_bf16(s0[4], s0[5]); w.w = cvt_pk_bf16(s0[6], s0[7]); pf[0] = *(bf16x8*)&w;
            w.x = cvt_pk_bf16(s0[8], s0[9]); w.y = cvt_pk_bf16(s0[10], s0[11]); w.z = cvt_pk_bf16(s0[12], s0[13]); w.w = cvt_pk_bf16(s0[14], s0[15]); pf[1] = *(bf16x8*)&w;
            w.x = cvt_pk_bf16(s1[0], s1[1]); w.y = cvt_pk_bf16(s1[2], s1[3]); w.z = cvt_pk_bf16(s1[4], s1[5]); w.w = cvt_pk_bf16(s1[6], s1[7]); pf[2] = *(bf16x8*)&w;
            w.x = cvt_pk_bf16(s1[8], s1[9]); w.y = cvt_pk_bf16(s1[10], s1[11]); w.z = cvt_pk_bf16(s1[12], s1[13]); w.w = cvt_pk_bf16(s1[14], s1[15]); pf[3] = *(bf16x8*)&w;
        }
        {
            const unsigned va = vlane + (unsigned)(buf * G::VBUF);
            pv_block2<0, 1>(o[0], o[1], va, pf); pv_block2<2, 3>(o[2], o[3], va, pf);
        }
        }
        if (t + 1 < NT) ATT_WRITE(buf ^ 1);
        __syncthreads();
    }
    l += __shfl_xor(l, 32);
    const float inv = 1.f / l;
    store_tile_32x128(lds + wave * (32 * 272), o, inv, op + (size_t)wrow * opitch + whead, opitch, lane);
#undef ATT_LOAD
#undef ATT_WRITE
}

constexpr int ML_KWSTR = 320;
constexpr int ML_VSTR  = 576;
constexpr int ML_CSTR  = 272;

__device__ __forceinline__ int ml_rowbase(int b, int c) { return c == 0 ? RL + b * CTX : b * SEQ + (c - 1) * 256; }

__device__ __forceinline__ float ml_gates(LAS float* bt, LAS float* ip, LAS float* sbuf, const bf16_t* __restrict__ z1, const float* __restrict__ gate_b, int rbase, int h, int dir) {
    const int tid = threadIdx.x;
    const int j = dir ? 255 - tid : tid;
    if (tid < 256) {
        const bf16_t* zr = z1 + (size_t)(rbase + tid) * 6400 + 6144 + dir * 8 + h;
        const float gi = bf2f(zr[0]) + gate_b[dir * 8 + h];
        const float gf = bf2f(zr[16]) + gate_b[16 + dir * 8 + h];
        const float lf = fminf(gf, 0.f) - log1pf(__expf(-fabsf(gf)));
        ip[tid] = gi; sbuf[j] = lf;
    }
    __syncthreads();
    for (int off = 1; off < 256; off <<= 1) {
        float v = 0.f;
        if (tid < 256 && tid >= off) v = sbuf[tid - off];
        __syncthreads();
        if (tid < 256) sbuf[tid] += v;
        __syncthreads();
    }
    if (tid < 256) bt[tid] = sbuf[j];
    const float bend = sbuf[255];
    __syncthreads();
    return bend;
}

__device__ __forceinline__ void ph_ml_p1(LAS unsigned char* lds, const bf16_t* __restrict__ z1, const float* __restrict__ gate_b, bf16_t* __restrict__ DC, float* __restrict__ DN, float* __restrict__ AC, float* __restrict__ GB, int lid) {
    const int tid = threadIdx.x, wave = tid >> 6, lane = tid & 63, r32 = lane & 31, hi = lane >> 5;
    LAS float* bt = (LAS float*)lds; LAS float* ip = bt + 256; LAS float* sbuf = ip + 256; LAS float* wv = sbuf + 256;
    constexpr int P1BUF = 64 * ML_KWSTR + 64 * ML_VSTR;
    LAS unsigned char* tb = lds + 4096;
    const unsigned lane_off = (unsigned)((4 * hi + ((lane & 15) >> 2))) ;
    const unsigned kaddr0 = (unsigned)(size_t)tb + lane_off * ML_KWSTR + ((lane >> 4) & 1) * 32 + (lane & 3) * 8;
    const unsigned vaddr0 = (unsigned)(size_t)(tb + 64 * ML_KWSTR) + lane_off * ML_VSTR + ((lane >> 4) & 1) * 32 + (lane & 3) * 8 + wave * 64;
    for (int item = lid; item < 1088; item += gridDim.x) {
        const int c = item % 17, seq = item / 17, dir = seq & 1, h = (seq >> 1) & 7, b = seq >> 4;
        const int rbase = ml_rowbase(b, c);
        u32x4 kreg[2], vreg[4];
#define P1_LOAD(st_) do { \
            _Pragma("unroll") for (int i_ = 0; i_ < 2; ++i_) { const int id_ = tid + i_ * NTHREADS, rr_ = id_ >> 4, cc_ = id_ & 15; \
                kreg[i_] = *(const u32x4*)(z1 + (size_t)(rbase + (st_) * 64 + rr_) * 6400 + 1024 + h * 128 + cc_ * 8); } \
            _Pragma("unroll") for (int i_ = 0; i_ < 4; ++i_) { const int id_ = tid + i_ * NTHREADS, rr_ = id_ >> 5, cc_ = id_ & 31; \
                vreg[i_] = *(const u32x4*)(z1 + (size_t)(rbase + (st_) * 64 + rr_) * 6400 + 2048 + h * 256 + cc_ * 8); } } while (0)
#define P1_WRITE(st_, buf_) do { LAS unsigned char* kw_ = tb + (buf_) * P1BUF; LAS unsigned char* vt_ = kw_ + 64 * ML_KWSTR; \
            _Pragma("unroll") for (int i_ = 0; i_ < 2; ++i_) { const int id_ = tid + i_ * NTHREADS, rr_ = id_ >> 4, cc_ = id_ & 15; \
                const u32x4 kx_ = kreg[i_]; const float w_ = wv[(st_) * 64 + rr_]; u32x4 o_; \
                o_.x = cvt_pk_bf16(bflo(kx_.x) * w_, bfhi(kx_.x) * w_); o_.y = cvt_pk_bf16(bflo(kx_.y) * w_, bfhi(kx_.y) * w_); \
                o_.z = cvt_pk_bf16(bflo(kx_.z) * w_, bfhi(kx_.z) * w_); o_.w = cvt_pk_bf16(bflo(kx_.w) * w_, bfhi(kx_.w) * w_); \
                *(LAS u32x4*)(kw_ + rr_ * ML_KWSTR + cc_ * 16) = o_; } \
            _Pragma("unroll") for (int i_ = 0; i_ < 4; ++i_) { const int id_ = tid + i_ * NTHREADS, rr_ = id_ >> 5, cc_ = id_ & 31; \
                *(LAS u32x4*)(vt_ + rr_ * ML_VSTR + cc_ * 16) = vreg[i_]; } } while (0)
        P1_LOAD(0);
        const float bend = ml_gates(bt, ip, sbuf, z1, gate_b, rbase, h, dir);
        if (tid < 256) {
            wv[tid] = __expf(bend - bt[tid] + ip[tid]);
            GB[(size_t)item * 512 + tid] = bt[tid]; GB[(size_t)item * 512 + 256 + tid] = ip[tid];
        }
        __syncthreads();
        P1_WRITE(0, 0);
        __syncthreads();
        f32x16 acc[4];
#pragma unroll
        for (int dt = 0; dt < 4; ++dt)
#pragma unroll
            for (int r = 0; r < 16; ++r) acc[dt][r] = 0.f;
        float dn = 0.f;
#pragma unroll 1
        for (int st = 0; st < 4; ++st) {
            const int buf = st & 1;
            if (st + 1 < 4) P1_LOAD(st + 1);
            const LAS unsigned char* kw = tb + buf * P1BUF;
            {
                const LAS unsigned char* kc = kw + (tid >> 7) * 16 * ML_KWSTR + (tid & 127) * 2;
#pragma unroll
                for (int s_ = 0; s_ < 16; ++s_) dn += bf2f(*(const LAS bf16_t*)(kc + s_ * ML_KWSTR));
            }
            const unsigned kaddr = kaddr0 + (unsigned)(buf * P1BUF), vaddr = vaddr0 + (unsigned)(buf * P1BUF);
#define ML_P1_STEP(KS) do { \
                const s16x4 al = tr_read<(KS * 16 + 0) * ML_VSTR>(vaddr), ah = tr_read<(KS * 16 + 8) * ML_VSTR>(vaddr); \
                const s16x4 b0l = tr_read<(KS * 16 + 0) * ML_KWSTR + 0>(kaddr), b0h = tr_read<(KS * 16 + 8) * ML_KWSTR + 0>(kaddr); \
                const s16x4 b1l = tr_read<(KS * 16 + 0) * ML_KWSTR + 64>(kaddr), b1h = tr_read<(KS * 16 + 8) * ML_KWSTR + 64>(kaddr); \
                const s16x4 b2l = tr_read<(KS * 16 + 0) * ML_KWSTR + 128>(kaddr), b2h = tr_read<(KS * 16 + 8) * ML_KWSTR + 128>(kaddr); \
                const s16x4 b3l = tr_read<(KS * 16 + 0) * ML_KWSTR + 192>(kaddr), b3h = tr_read<(KS * 16 + 8) * ML_KWSTR + 192>(kaddr); \
                asm volatile("s_waitcnt lgkmcnt(0)" ::: "memory"); __builtin_amdgcn_sched_barrier(0); \
                const bf16x8 af = PK8(al, ah); \
                acc[0] = MFMA32(PK8(b0l, b0h), af, acc[0]); acc[1] = MFMA32(PK8(b1l, b1h), af, acc[1]); \
                acc[2] = MFMA32(PK8(b2l, b2h), af, acc[2]); acc[3] = MFMA32(PK8(b3l, b3h), af, acc[3]); } while (0)
            ML_P1_STEP(0); ML_P1_STEP(1); ML_P1_STEP(2); ML_P1_STEP(3);
#undef ML_P1_STEP
            if (st + 1 < 4) P1_WRITE(st + 1, buf ^ 1);
            __syncthreads();
        }
#undef P1_LOAD
#undef P1_WRITE
        store_tile_32x128(tb + wave * (32 * 272), acc, 1.0f, DC + (size_t)item * 32768 + (size_t)(32 * wave) * 128, 128, lane);
        sbuf[tid] = dn;
        __syncthreads();
        if (tid < 128) DN[(size_t)item * 128 + tid] = sbuf[tid] + sbuf[128 + tid] + sbuf[256 + tid] + sbuf[384 + tid];
        if (tid == 0) AC[item] = __expf(bend);
        __syncthreads();
    }
}

__device__ __forceinline__ void ph_ml_p2(const bf16_t* __restrict__ DC, const float* __restrict__ DN, const float* __restrict__ AC, bf16_t* __restrict__ CS, float* __restrict__ NS) {
    const int gt = blockIdx.x * NTHREADS + threadIdx.x, gn = gridDim.x * NTHREADS;
    for (int i = gt; i < 64 * 8192; i += gn) {
        const int seq = i >> 13, e4 = i & 8191, dir = seq & 1;
        f32x4 C = {0.f, 0.f, 0.f, 0.f};
        u32x2 dcr[16]; float acr[16];
#pragma unroll
        for (int j = 0; j < 16; ++j) { const int c = dir ? (j == 0 ? 0 : 17 - j) : j; const size_t item = (size_t)seq * 17 + c; dcr[j] = __builtin_nontemporal_load((const u32x2*)(DC + item * 32768 + e4 * 4)); acr[j] = AC[item]; }
#pragma unroll
        for (int j = 0; j < 17; ++j) {
            const int c = dir ? (j == 0 ? 0 : 17 - j) : j;
            const size_t item = (size_t)seq * 17 + c;
            u32x2 w; w.x = cvt_pk_bf16(C[0], C[1]); w.y = cvt_pk_bf16(C[2], C[3]);
            *(u32x2*)(CS + item * 32768 + e4 * 4) = w;
            if (j < 16) { const float a = acr[j]; const u32x2 dw = dcr[j]; f32x4 d; d[0] = bflo(dw.x); d[1] = bfhi(dw.x); d[2] = bflo(dw.y); d[3] = bfhi(dw.y); C = C * a + d; }
        }
    }
    for (int i = gt; i < 64 * 128; i += gn) {
        const int seq = i >> 7, e = i & 127, dir = seq & 1;
        float n = 0.f;
        for (int j = 0; j < 17; ++j) {
            const int c = dir ? (j == 0 ? 0 : 17 - j) : j;
            const size_t item = (size_t)seq * 17 + c;
            NS[item * 128 + e] = n;
            if (j < 16) n = n * AC[item] + DN[item * 128 + e];
        }
    }
}

__device__ __forceinline__ void ph_ml_p3(LAS unsigned char* lds, const bf16_t* __restrict__ z1, const float* __restrict__ GB, const bf16_t* __restrict__ CS, const float* __restrict__ NS, bf16_t* __restrict__ HD, int lid) {
    const int tid = threadIdx.x, wave = tid >> 6, lane = tid & 63, r32 = lane & 31, hi = lane >> 5;
    LAS float* bt = (LAS float*)lds; LAS float* ck = bt + 256; LAS float* nst = ck + 256;
    LAS unsigned char* cst = lds + 4096;
    LAS unsigned char* tb = cst + 128 * ML_CSTR;
    constexpr int P3BUF = 64 * ML_CSTR + 64 * VSTR;
    const unsigned vlane0 = (unsigned)(size_t)(tb + 64 * ML_CSTR) + (unsigned)((4 * hi + ((lane & 15) >> 2)) * VSTR + ((lane >> 4) & 1) * 32 + (lane & 3) * 8);
    for (int it = lid; it < 2176; it += gridDim.x) {
        const int vh = it & 1, item = it >> 1;
        const int c = item % 17, seq = item / 17, dir = seq & 1, h = (seq >> 1) & 7, b = seq >> 4;
        const int rbase = ml_rowbase(b, c);
        u32x4 kA[2], vA[2], kB[2], vB[2];
#define P3_LOAD(KR, VR, kt_) do { \
            _Pragma("unroll") for (int i_ = 0; i_ < 2; ++i_) { const int id_ = tid + i_ * NTHREADS, rr_ = id_ >> 4, cc_ = id_ & 15; const size_t ro_ = (size_t)(rbase + (kt_) * 64 + rr_) * 6400; \
                KR[i_] = *(const u32x4*)(z1 + ro_ + 1024 + h * 128 + cc_ * 8); VR[i_] = *(const u32x4*)(z1 + ro_ + 2048 + h * 256 + vh * 128 + cc_ * 8); } } while (0)
#define P3_WRITE(KR, VR, buf_) do { LAS unsigned char* kt_ = tb + (buf_) * P3BUF; LAS unsigned char* vt_ = kt_ + 64 * ML_CSTR; \
            _Pragma("unroll") for (int i_ = 0; i_ < 2; ++i_) { const int id_ = tid + i_ * NTHREADS, rr_ = id_ >> 4, cc_ = id_ & 15; \
                *(LAS u32x4*)(kt_ + rr_ * ML_CSTR + cc_ * 16) = KR[i_]; *(LAS u32x4*)(vt_ + rr_ * VSTR + cc_ * 16) = VR[i_]; } } while (0)
        __syncthreads();
        P3_LOAD(kA, vA, 0); P3_LOAD(kB, vB, 1);
        if (tid < 256) { const float bv = GB[(size_t)item * 512 + tid], iv = GB[(size_t)item * 512 + 256 + tid]; bt[tid] = bv; ck[tid] = iv - bv; }
        if (tid < 128) nst[tid] = NS[(size_t)item * 128 + tid];
#pragma unroll
        for (int i = 0; i < 4; ++i) {
            const int id = tid + i * NTHREADS, rr = id >> 4, cc = id & 15;
            const u32x4 x = *(const u32x4*)(CS + (size_t)item * 32768 + (size_t)(vh * 128 + rr) * 128 + cc * 8);
            *(LAS u32x4*)(cst + rr * ML_CSTR + cc * 16) = x;
        }
        const int tq = wave * 32 + r32;
        bf16x8 qf[8];
        {
            const bf16_t* qrow = z1 + (size_t)(rbase + tq) * 6400 + h * 128 + hi * 8;
#pragma unroll
            for (int j = 0; j < 8; ++j) qf[j] = *(const bf16x8*)(qrow + j * 16);
        }
        P3_WRITE(kA, vA, 0);
        __syncthreads();
        const float bq = bt[tq];
        const float g = __expf(bq);
        f32x16 o[4];
#pragma unroll
        for (int c4 = 0; c4 < 4; ++c4)
#pragma unroll
            for (int r = 0; r < 16; ++r) o[c4][r] = 0.f;
        float den = 0.f;
        {
            const LAS unsigned char* cb = cst + r32 * ML_CSTR + hi * 16;
#pragma unroll
            for (int j = 0; j < 8; ++j) {
#pragma unroll
                for (int c4 = 0; c4 < 4; ++c4) { const bf16x8 a = *(const LAS bf16x8*)(cb + c4 * 32 * ML_CSTR + j * 32); o[c4] = MFMA32(a, qf[j], o[c4]); }
                const f32x4 n0 = *(const LAS f32x4*)(nst + 16 * j + 8 * hi), n1 = *(const LAS f32x4*)(nst + 16 * j + 8 * hi + 4);
                const u32x4 qw = *(const u32x4*)&qf[j];
                den += bflo(qw.x) * n0[0] + bfhi(qw.x) * n0[1] + bflo(qw.y) * n0[2] + bfhi(qw.y) * n0[3] + bflo(qw.z) * n1[0] + bfhi(qw.z) * n1[1] + bflo(qw.w) * n1[2] + bfhi(qw.w) * n1[3];
            }
#pragma unroll
            for (int c4 = 0; c4 < 4; ++c4)
#pragma unroll
                for (int r = 0; r < 16; ++r) o[c4][r] *= g;
            den *= g;
        }
#define P3_TILE(kti, buf) do { \
            const bool rel = dir ? (64 * kti + 63 >= 32 * wave) : (64 * kti <= 32 * wave + 31); \
            if (rel) { \
                f32x16 s0, s1; \
_Pragma("unroll") \
                for (int r = 0; r < 16; ++r) { s0[r] = 0.f; s1[r] = 0.f; } \
                const LAS unsigned char* kb = tb + buf * P3BUF + r32 * ML_CSTR + hi * 16; \
_Pragma("unroll") \
                for (int j = 0; j < 8; ++j) { \
                    const bf16x8 a0 = *(const LAS bf16x8*)(kb + j * 32), a1 = *(const LAS bf16x8*)(kb + 32 * ML_CSTR + j * 32); \
                    s0 = MFMA32(a0, qf[j], s0); s1 = MFMA32(a1, qf[j], s1); \
                } \
                float ps = 0.f; \
_Pragma("unroll") \
                for (int gq = 0; gq < 4; ++gq) { \
                    const int k0 = 64 * kti + 8 * gq + 4 * hi; \
                    const f32x4 c0 = *(const LAS f32x4*)(ck + k0), c1 = *(const LAS f32x4*)(ck + k0 + 32); \
_Pragma("unroll") \
                    for (int e = 0; e < 4; ++e) { \
                        const int ts0 = k0 + e, ts1 = ts0 + 32; \
                        const bool v0 = dir ? (ts0 >= tq) : (ts0 <= tq), v1 = dir ? (ts1 >= tq) : (ts1 <= tq); \
                        const float w0 = v0 ? __expf(bq + c0[e]) : 0.f, w1 = v1 ? __expf(bq + c1[e]) : 0.f; \
                        const float p0 = s0[4 * gq + e] * w0, p1 = s1[4 * gq + e] * w1; \
                        s0[4 * gq + e] = p0; s1[4 * gq + e] = p1; ps += p0 + p1; \
                    } \
                } \
                den += ps; \
                bf16x8 pf[4]; \
                { \
                    u32x4 w; \
                    w.x = cvt_pk_bf16(s0[0], s0[1]); w.y = cvt_pk_bf16(s0[2], s0[3]); w.z = cvt_pk_bf16(s0[4], s0[5]); w.w = cvt_pk_bf16(s0[6], s0[7]); pf[0] = *(bf16x8*)&w; \
                    w.x = cvt_pk_bf16(s0[8], s0[9]); w.y = cvt_pk_bf16(s0[10], s0[11]); w.z = cvt_pk_bf16(s0[12], s0[13]); w.w = cvt_pk_bf16(s0[14], s0[15]); pf[1] = *(bf16x8*)&w; \
                    w.x = cvt_pk_bf16(s1[0], s1[1]); w.y = cvt_pk_bf16(s1[2], s1[3]); w.z = cvt_pk_bf16(s1[4], s1[5]); w.w = cvt_pk_bf16(s1[6], s1[7]); pf[2] = *(bf16x8*)&w; \
                    w.x = cvt_pk_bf16(s1[8], s1[9]); w.y = cvt_pk_bf16(s1[10], s1[11]); w.z = cvt_pk_bf16(s1[12], s1[13]); w.w = cvt_pk_bf16(s1[14], s1[15]); pf[3] = *(bf16x8*)&w; \
                } \
                const unsigned vlane = vlane0 + (unsigned)(buf * P3BUF); \
                pv_block<0>(o[0], vlane, pf); pv_block<1>(o[1], vlane, pf); pv_block<2>(o[2], vlane, pf); pv_block<3>(o[3], vlane, pf); \
            } \
        } while (0)
#pragma unroll 1
        for (int kp = 0; kp < 2; ++kp) {
            if (kp == 0) P3_LOAD(kA, vA, 2);
            P3_TILE((2 * kp), 0);
            P3_WRITE(kB, vB, 1);
            __syncthreads();
            if (kp == 0) P3_LOAD(kB, vB, 3);
            P3_TILE((2 * kp + 1), 1);
            if (kp == 0) P3_WRITE(kA, vA, 0);
            __syncthreads();
        }
#undef P3_TILE
#undef P3_LOAD
#undef P3_WRITE
        den += __shfl_xor(den, 32);
        const float inv = 1.f / fmaxf(fabsf(den), 1.f);
        store_tile_32x128(tb + wave * (32 * 272), o, inv, HD + (size_t)dir * RA * DM + (size_t)(rbase + wave * 32) * DM + h * 256 + vh * 128, DM, lane);
    }
}

#define FP(i) ((i) + 2 * ((i) >> 4))
constexpr int FFT_BUF_BYTES = (8192 + 2 * 512) * 8;
__device__ __forceinline__ f32x2 cmul(f32x2 a, f32x2 b) { f32x2 r; r.x = a.x * b.x - a.y * b.y; r.y = a.x * b.y + a.y * b.x; return r; }
__device__ __forceinline__ f32x2 cmulc(f32x2 a, f32x2 b) { f32x2 r; r.x = a.x * b.x + a.y * b.y; r.y = a.y * b.x - a.x * b.y; return r; }
__device__ __forceinline__ f32x2 mul_mi(f32x2 a) { f32x2 r; r.x = a.y; r.y = -a.x; return r; }
template <bool INV> __device__ __forceinline__ void bfly(f32x2& a, f32x2& b, f32x2 w) {
    if (!INV) { const f32x2 s = a + b, d = a - b; a = s; b = cmul(d, w); }
    else { const f32x2 t = cmulc(b, w); const f32x2 s = a + t, d = a - t; a = s; b = d; }
}
__device__ __forceinline__ void b_1(f32x2& a, f32x2& b) { const f32x2 s = a + b, d = a - b; a = s; b = d; }
__device__ __forceinline__ void f_mi(f32x2& a, f32x2& b) { const f32x2 s = a + b, d = a - b; a = s; b.x = d.y; b.y = -d.x; }
__device__ __forceinline__ void f_c1(f32x2& a, f32x2& b) { const float r = 0.70710678118654752f; const f32x2 s = a + b, d = a - b; a = s; b.x = r * (d.x + d.y); b.y = r * (d.y - d.x); }
__device__ __forceinline__ void f_c3(f32x2& a, f32x2& b) { const float r = 0.70710678118654752f; const f32x2 s = a + b, d = a - b; a = s; b.x = r * (d.y - d.x); b.y = -r * (d.x + d.y); }
__device__ __forceinline__ void i_mi(f32x2& a, f32x2& b) { f32x2 t; t.x = -b.y; t.y = b.x; const f32x2 s = a + t, d = a - t; a = s; b = d; }
__device__ __forceinline__ void i_c1(f32x2& a, f32x2& b) { const float r = 0.70710678118654752f; f32x2 t; t.x = r * (b.x - b.y); t.y = r * (b.x + b.y); const f32x2 s = a + t, d = a - t; a = s; b = d; }
__device__ __forceinline__ void i_c3(f32x2& a, f32x2& b) { const float r = 0.70710678118654752f; f32x2 t; t.x = -r * (b.x + b.y); t.y = r * (b.x - b.y); const f32x2 s = a + t, d = a - t; a = s; b = d; }
template <bool INV> __device__ __forceinline__ void radix8(f32x2 (&e)[8], const LAS f32x2* twp, int i1) {
    const f32x2 t1 = twp[i1], t2 = cmul(t1, t1), t3 = cmul(t1, t2), t4 = cmul(t2, t2), t5 = cmul(t1, t4), t6 = cmul(t2, t4), t7 = cmul(t3, t4);
    if (!INV) {
        b_1(e[0], e[4]); f_c1(e[1], e[5]); f_mi(e[2], e[6]); f_c3(e[3], e[7]);
        b_1(e[0], e[2]); f_mi(e[1], e[3]); b_1(e[4], e[6]); f_mi(e[5], e[7]);
        b_1(e[0], e[1]); b_1(e[2], e[3]); b_1(e[4], e[5]); b_1(e[6], e[7]);
        e[1] = cmul(e[1], t4); e[2] = cmul(e[2], t2); e[3] = cmul(e[3], t6); e[4] = cmul(e[4], t1); e[5] = cmul(e[5], t5); e[6] = cmul(e[6], t3); e[7] = cmul(e[7], t7);
    } else {
        e[1] = cmulc(e[1], t4); e[2] = cmulc(e[2], t2); e[3] = cmulc(e[3], t6); e[4] = cmulc(e[4], t1); e[5] = cmulc(e[5], t5); e[6] = cmulc(e[6], t3); e[7] = cmulc(e[7], t7);
        b_1(e[0], e[1]); b_1(e[2], e[3]); b_1(e[4], e[5]); b_1(e[6], e[7]);
        b_1(e[0], e[2]); i_mi(e[1], e[3]); b_1(e[4], e[6]); i_mi(e[5], e[7]);
        b_1(e[0], e[4]); i_c1(e[1], e[5]); i_mi(e[2], e[6]); i_c3(e[3], e[7]);
    }
}
template <bool INV> __device__ __forceinline__ void radix16(f32x2 (&e)[16]) {
    const float c1 = 0.92387953251128674f, s1 = 0.38268343236508977f;
    f32x2 w1, w3, w5, w7; w1.x = c1; w1.y = -s1; w3.x = s1; w3.y = -c1; w5.x = -s1; w5.y = -c1; w7.x = -c1; w7.y = -s1;
    if (!INV) {
        b_1(e[0], e[8]); bfly<false>(e[1], e[9], w1); f_c1(e[2], e[10]); bfly<false>(e[3], e[11], w3); f_mi(e[4], e[12]); bfly<false>(e[5], e[13], w5); f_c3(e[6], e[14]); bfly<false>(e[7], e[15], w7);
#pragma unroll
        for (int g = 0; g < 16; g += 8) { b_1(e[g], e[g + 4]); f_c1(e[g + 1], e[g + 5]); f_mi(e[g + 2], e[g + 6]); f_c3(e[g + 3], e[g + 7]); }
#pragma unroll
        for (int g = 0; g < 16; g += 4) { b_1(e[g], e[g + 2]); f_mi(e[g + 1], e[g + 3]); }
#pragma unroll
        for (int g = 0; g < 16; g += 2) b_1(e[g], e[g + 1]);
    } else {
#pragma unroll
        for (int g = 0; g < 16; g += 2) b_1(e[g], e[g + 1]);
#pragma unroll
        for (int g = 0; g < 16; g += 4) { b_1(e[g], e[g + 2]); i_mi(e[g + 1], e[g + 3]); }
#pragma unroll
        for (int g = 0; g < 16; g += 8) { b_1(e[g], e[g + 4]); i_c1(e[g + 1], e[g + 5]); i_mi(e[g + 2], e[g + 6]); i_c3(e[g + 3], e[g + 7]); }
        b_1(e[0], e[8]); bfly<true>(e[1], e[9], w1); i_c1(e[2], e[10]); bfly<true>(e[3], e[11], w3); i_mi(e[4], e[12]); bfly<true>(e[5], e[13], w5); i_c3(e[6], e[14]); bfly<true>(e[7], e[15], w7);
    }
}
template <bool INV, int LH, bool ZHI, bool LOH> __device__ __forceinline__ void fft_pass8_body(LAS f32x2* buf, const LAS f32x2* tw, int tid) {
    constexpr int LQ = LH - 2, Q4 = 1 << LQ, STEP = Q4 + Q4 / 8;
    asm volatile("" : "+v"(tid));
#pragma unroll
    for (int it = 0; it < 2; ++it) {
        const int j = tid + it * NTHREADS, blk = j >> LQ, pos = j & (Q4 - 1), base = (blk << (LH + 1)) + pos;
        const int i1 = pos << (12 - LH);
        LAS f32x2* pb = buf + FP(base);
        f32x2 e[8];
#pragma unroll
        for (int m = 0; m < 8; ++m) {
            if (ZHI && m >= 4) { e[m].x = 0.f; e[m].y = 0.f; }
            else e[m] = pb[m * STEP];
        }
        radix8<INV>(e, tw, i1);
#pragma unroll
        for (int m = 0; m < 8; ++m) { if (!(LOH && m >= 4)) pb[m * STEP] = e[m]; }
    }
}
template <bool INV, int LH, bool ZHI, bool LOH> __device__ __forceinline__ void fft_pass8(LAS f32x2* buf, const LAS f32x2* tw, int tid) {
    fft_pass8_body<INV, LH, ZHI, LOH>(buf, tw, tid);
    __syncthreads();
}
template <bool INV, int LH, bool ZHI, bool LOH> __device__ __forceinline__ void fft_pass8x2(LAS f32x2* A, LAS f32x2* B, const LAS f32x2* tw, int tid) {
    fft_pass8_body<INV, LH, ZHI, LOH>(A, tw, tid);
    __builtin_amdgcn_sched_barrier(0);
    fft_pass8_body<INV, LH, ZHI, LOH>(B, tw, tid);
    __syncthreads();
}
__device__ __forceinline__ void ld16(f32x2 (&e)[16], const LAS f32x2* p) {
#pragma unroll
    for (int m = 0; m < 8; ++m) { const f32x4 v = *(const LAS f32x4*)(p + 2 * m); e[2 * m].x = v[0]; e[2 * m].y = v[1]; e[2 * m + 1].x = v[2]; e[2 * m + 1].y = v[3]; }
}
__device__ __forceinline__ void st16(const f32x2 (&e)[16], LAS f32x2* p) {
#pragma unroll
    for (int m = 0; m < 8; ++m) { f32x4 v; v[0] = e[2 * m].x; v[1] = e[2 * m].y; v[2] = e[2 * m + 1].x; v[3] = e[2 * m + 1].y; *(LAS f32x4*)(p + 2 * m) = v; }
}
__device__ __forceinline__ void fft_fwd_regs(LAS f32x2* buf, const LAS f32x2* tw, f32x2 (&hreg)[16]) {
    int tid = threadIdx.x; asm volatile("" : "+v"(tid));
    fft_pass8<false, 12, false, false>(buf, tw, tid); fft_pass8<false, 9, false, false>(buf, tw, tid); fft_pass8<false, 6, false, false>(buf, tw, tid);
    ld16(hreg, buf + 18 * tid); radix16<false>(hreg);
    __syncthreads();
}
__device__ __forceinline__ void fft_conv2(LAS f32x2* XA, LAS f32x2* XB, const f32x2 (&hreg)[16], const LAS f32x2* tw) {
    int tid = threadIdx.x; asm volatile("" : "+v"(tid));
    fft_pass8x2<false, 12, true, false>(XA, XB, tw, tid); fft_pass8x2<false, 9, false, false>(XA, XB, tw, tid); fft_pass8x2<false, 6, false, false>(XA, XB, tw, tid);
#pragma unroll
    for (int hb = 0; hb < 2; ++hb) {
        f32x2 e[16]; LAS f32x2* p = (hb ? XB : XA) + 18 * tid;
        ld16(e, p);
        radix16<false>(e);
#pragma unroll
        for (int m = 0; m < 16; ++m) e[m] = cmul(e[m], hreg[m]);
        radix16<true>(e);
        st16(e, p);
        __builtin_amdgcn_sched_barrier(0);
    }
    __syncthreads();
    asm volatile("" : "+v"(tid));
    fft_pass8x2<true, 6, false, false>(XA, XB, tw, tid); fft_pass8x2<true, 9, false, false>(XA, XB, tw, tid); fft_pass8x2<true, 12, false, true>(XA, XB, tw, tid);
}

struct HyRaw { u32x4 q; unsigned lr; };
__device__ __forceinline__ void hy_raw_load(HyRaw& R, const bf16_t* __restrict__ zrow, int t0) {
    R.q = *(const u32x4*)(zrow + t0);
    const unsigned l = t0 > 0 ? (unsigned)zrow[t0 - 1] : 0u, r = t0 + 8 < SEQ ? (unsigned)zrow[t0 + 8] : 0u;
    R.lr = l | (r << 16);
}
__device__ __forceinline__ void hy_sc8(float (&out)[8], const HyRaw& R, float w0, float w1, float w2, float cb) {
    float z[10];
    z[0] = bflo(R.lr); z[1] = bflo(R.q.x); z[2] = bfhi(R.q.x); z[3] = bflo(R.q.y); z[4] = bfhi(R.q.y); z[5] = bflo(R.q.z); z[6] = bfhi(R.q.z); z[7] = bflo(R.q.w); z[8] = bfhi(R.q.w); z[9] = bfhi(R.lr);
#pragma unroll
    for (int e = 0; e < 8; ++e) out[e] = z[e] * w0 + z[e + 1] * w1 + z[e + 2] * w2 + cb;
}
struct HyF { u32x4 a, b; };
__device__ __forceinline__ void hy_f_load(HyF& f, const bf16_t* __restrict__ F, int col_f, int col_b, int t0) {
    f.a = *(const u32x4*)(F + (size_t)col_f * 4096 + t0); f.b = *(const u32x4*)(F + (size_t)col_b * 4096 + t0);
}
__device__ __forceinline__ void hy_filter(LAS f32x2* Hs, const HyF& f, int t0, int xo, const LAS f32x2* twl, f32x2 (&hreg)[16]) {
    __syncthreads();
    f32x4 w; w[1] = 0.f; w[3] = 0.f;
    w[0] = bflo(f.a.x); w[2] = bfhi(f.a.x); *(LAS f32x4*)(Hs + xo) = w; w[0] = bflo(f.a.y); w[2] = bfhi(f.a.y); *(LAS f32x4*)(Hs + xo + 2) = w;
    w[0] = bflo(f.a.z); w[2] = bfhi(f.a.z); *(LAS f32x4*)(Hs + xo + 4) = w; w[0] = bflo(f.a.w); w[2] = bfhi(f.a.w); *(LAS f32x4*)(Hs + xo + 6) = w;
    float fb[8];
    fb[0] = bflo(f.b.x); fb[1] = bfhi(f.b.x); fb[2] = bflo(f.b.y); fb[3] = bfhi(f.b.y); fb[4] = bflo(f.b.z); fb[5] = bfhi(f.b.z); fb[6] = bflo(f.b.w); fb[7] = bfhi(f.b.w);
#pragma unroll
    for (int e = 0; e < 8; ++e) {
        const int l = t0 + e; f32x2 v; v.y = 0.f; v.x = fb[e];
        if (l >= 1) Hs[FP(8192 - l)] = v; else { v.x = 0.f; Hs[FP(4096)] = v; }
    }
    __syncthreads();
    fft_fwd_regs(Hs, twl, hreg);
}
__device__ __forceinline__ void hy_stage(LAS f32x2* X, int xo, const float (&v0)[8], const float (&v1)[8]) {
#pragma unroll
    for (int e = 0; e < 8; e += 2) { f32x4 w; w[0] = v0[e]; w[1] = v1[e]; w[2] = v0[e + 1]; w[3] = v1[e + 1]; *(LAS f32x4*)(X + xo + e) = w; }
}
__device__ __forceinline__ void hy_finish(const LAS f32x2* X, int xo, const float (&v0)[8], const float (&v1)[8], const float (&g0)[8], const float (&g1)[8], float sk, float (&r0)[8], float (&r1)[8]) {
#pragma unroll
    for (int e = 0; e < 8; e += 2) {
        const f32x4 c = *(const LAS f32x4*)(X + xo + e);
        r0[e] = g0[e] * (c[0] * (1.0f / 8192.0f) + v0[e] * sk); r1[e] = g1[e] * (c[1] * (1.0f / 8192.0f) + v1[e] * sk);
        r0[e + 1] = g0[e + 1] * (c[2] * (1.0f / 8192.0f) + v0[e + 1] * sk); r1[e + 1] = g1[e + 1] * (c[3] * (1.0f / 8192.0f) + v1[e + 1] * sk);
    }
}
__device__ __forceinline__ void st8_bf16(bf16_t* p, const float (&r)[8]) { u32x4 w; w.x = cvt_pk_bf16(r[0], r[1]); w.y = cvt_pk_bf16(r[2], r[3]); w.z = cvt_pk_bf16(r[4], r[5]); w.w = cvt_pk_bf16(r[6], r[7]); *(u32x4*)p = w; }

__device__ __forceinline__ void ph_hyena(LAS unsigned char* lds, const bf16_t* __restrict__ ZT, const float* __restrict__ conv_w, const float* __restrict__ conv_b,
                                         const bf16_t* __restrict__ F, const float* __restrict__ skip, const f32x2* __restrict__ tw, bf16_t* __restrict__ Y2T) {
    LAS f32x2* XA = (LAS f32x2*)lds;
    LAS f32x2* XB = (LAS f32x2*)(lds + FFT_BUF_BYTES);
    LAS f32x2* twl = (LAS f32x2*)(lds + LDS_TWL);
    const int tid = threadIdx.x, t0 = tid * 8;
    const int xo = FP(t0);
    __syncthreads();
    for (int i = tid; i < 1024; i += NTHREADS) twl[i] = tw[i];
    HyF fc; HyRaw rv[4], rg[4], rg2[4];
    int ch = blockIdx.x;
    if (ch < DM) {
        hy_f_load(fc, F, ch, 2 * DM + ch, t0);
#pragma unroll
        for (int b = 0; b < 4; ++b) hy_raw_load(rv[b], ZT + (size_t)(2 * DM + ch) * RL + b * SEQ, t0);
    }
#pragma unroll 1
    for (; ch < DM; ch += gridDim.x) {
        const int cv = 2 * DM + ch, cx1 = ch, cx2 = DM + ch;
        const float vw0 = conv_w[cv], vw1 = conv_w[3 * DM + cv], vw2 = conv_w[6 * DM + cv], vb = conv_b[cv];
        const float aw0 = conv_w[cx1], aw1 = conv_w[3 * DM + cx1], aw2 = conv_w[6 * DM + cx1], ab = conv_b[cx1];
        const float bw0 = conv_w[cx2], bw1 = conv_w[3 * DM + cx2], bw2 = conv_w[6 * DM + cx2], bb = conv_b[cx2];
        const float sk0 = skip[ch], sk1 = skip[DM + ch];
        f32x2 hreg[16];
        float v[4][8], g0[8], g1[8];
        hy_filter(XB, fc, t0, xo, twl, hreg);
#pragma unroll
        for (int b = 0; b < 4; ++b) hy_sc8(v[b], rv[b], vw0, vw1, vw2, vb);
        hy_stage(XA, xo, v[0], v[1]); hy_stage(XB, xo, v[2], v[3]);
        hy_f_load(fc, F, DM + ch, 3 * DM + ch, t0);
#pragma unroll
        for (int b = 0; b < 4; ++b) { hy_raw_load(rg[b], ZT + (size_t)cx1 * RL + b * SEQ, t0); hy_raw_load(rg2[b], ZT + (size_t)cx2 * RL + b * SEQ, t0); }
        __syncthreads();
        fft_conv2(XA, XB, hreg, twl);
        hy_sc8(g0, rg[0], aw0, aw1, aw2, ab); hy_sc8(g1, rg[1], aw0, aw1, aw2, ab);
        hy_finish(XA, xo, v[0], v[1], g0, g1, sk0, v[0], v[1]);
        hy_sc8(g0, rg[2], aw0, aw1, aw2, ab); hy_sc8(g1, rg[3], aw0, aw1, aw2, ab);
        hy_finish(XB, xo, v[2], v[3], g0, g1, sk0, v[2], v[3]);
        hy_filter(XB, fc, t0, xo, twl, hreg);
        hy_stage(XA, xo, v[0], v[1]); hy_stage(XB, xo, v[2], v[3]);
        {
            const int cn = ch + (int)gridDim.x;
            if (cn < DM) {
                hy_f_load(fc, F, cn, 2 * DM + cn, t0);
#pragma unroll
                for (int b = 0; b < 4; ++b) hy_raw_load(rv[b], ZT + (size_t)(2 * DM + cn) * RL + b * SEQ, t0);
            }
        }
        __syncthreads();
        fft_conv2(XA, XB, hreg, twl);
        {
            float r0[8], r1[8];
            hy_sc8(g0, rg2[0], bw0, bw1, bw2, bb); hy_sc8(g1, rg2[1], bw0, bw1, bw2, bb);
            hy_finish(XA, xo, v[0], v[1], g0, g1, sk1, r0, r1);
            st8_bf16(Y2T + (size_t)ch * RL + 0 * SEQ + t0, r0); st8_bf16(Y2T + (size_t)ch * RL + 1 * SEQ + t0, r1);
            hy_sc8(g0, rg2[2], bw0, bw1, bw2, bb); hy_sc8(g1, rg2[3], bw0, bw1, bw2, bb);
            hy_finish(XB, xo, v[2], v[3], g0, g1, sk1, r0, r1);
            st8_bf16(Y2T + (size_t)ch * RL + 2 * SEQ + t0, r0); st8_bf16(Y2T + (size_t)ch * RL + 3 * SEQ + t0, r1);
        }
    }
}

constexpr int N_IN = 37;
enum { I_X = 0, I_C, I_CTX, I_CCTX, I_ADAW, I_ADAB, I_NORMG, I_W1, I_W2, I_SWQKV, I_SWSINK, I_SWWO, I_MLWIN, I_MLGB, I_MLHG, I_MLWO,
       I_MAWIN, I_MAQG, I_MAKVG, I_MAUQ, I_MAUKV, I_MAWO, I_HYWIN, I_HYCW, I_HYCB, I_HYW1, I_HYB1, I_HYW2, I_HYB2, I_HYW3, I_HYB3, I_HYW4, I_HYB4, I_HYFREQ, I_HYDECAY, I_HYSKIP, I_HYWO };
struct Args { const float* in[N_IN]; float* out; unsigned char* ws; int ph_lo, ph_hi; };
constexpr int N_PHASES = 36;

__global__ void __launch_bounds__(NTHREADS, 2) mk_fwd(Args args) {
    extern __shared__ __attribute__((aligned(16))) unsigned char lds_raw[];
    LAS unsigned char* lds = (LAS unsigned char*)lds_raw;
    unsigned char* ws = args.ws;
    const int tid = threadIdx.x;
    volatile LAS unsigned* misc = (volatile LAS unsigned*)(lds + LDS_MISC);
    if (tid < 4) misc[tid] = 0u;
    __syncthreads();
#if MK_ONE_LAUNCH
    XcdBarrier bar = xcd_barrier_post((unsigned*)(ws + WS_CTL), misc);
#define GRID_BAR() xcd_barrier(bar)
    if (tid == 0) { const unsigned xc = xb_xcc_id(); misc[4] = xc; misc[5] = xb_add((unsigned*)(ws + WS_CTL) + 3712 + xc, 1u); }
#else
#define GRID_BAR() do {} while (0)
#endif
    const int lo = args.ph_lo, hi = args.ph_hi;
#define IN(k) (lo <= (k) && (k) < hi)
#define SEAM(k) do { if (IN(k) && IN((k) + 1)) GRID_BAR(); } while (0)
#define PH_BEGIN(k) if (IN(k)) { _Pragma("unroll") for (int rep_ = 0; rep_ < 1; ++rep_) {
#define PH_END(k) } }

    const float* x = args.in[I_X]; const float* cin = args.in[I_CTX];
    float* mods = (float*)(ws + WS_MODS);
    const f32x2* ropeA = (const f32x2*)(ws + WS_ROPEA); const f32x2* ropeC = (const f32x2*)(ws + WS_ROPEC); const f32x2* tw = (const f32x2*)(ws + WS_TW);
    bf16_t* a3b = (bf16_t*)(ws + WS_A3T); bf16_t* w4tb = (bf16_t*)(ws + WS_W4TB);
    bf16_t* W1T = (bf16_t*)(ws + WS_W1T); bf16_t* W2T = (bf16_t*)(ws + WS_W2T);
    bf16_t* H = (bf16_t*)(ws + WS_H); bf16_t* U = (bf16_t*)(ws + WS_U); bf16_t* Y = (bf16_t*)(ws + WS_Y); bf16_t* YP = (bf16_t*)(ws + WS_YP); bf16_t* O = (bf16_t*)(ws + WS_O); bf16_t* T = (bf16_t*)(ws + WS_T);
    const float* normg = args.in[I_NORMG];
    constexpr float LOG2E = 1.4426950408889634f;

    PH_BEGIN(0)
        {
        ph_mods(lds, args.in[I_C], args.in[I_CCTX], args.in[I_ADAW], args.in[I_ADAB], mods);
        ph_tables((f32x2*)(ws + WS_ROPEA), (f32x2*)(ws + WS_ROPEC), (f32x2*)(ws + WS_TW));
        ph_hyena_feats(lds, args.in[I_HYW1], args.in[I_HYB1], args.in[I_HYW2], args.in[I_HYB2], args.in[I_HYW3], args.in[I_HYB3], args.in[I_HYFREQ], a3b);
        conv_w4(args.in[I_HYW4], w4tb);
        __syncthreads();
        const int pr = (int)blockIdx.x, pn = (int)gridDim.x;
        conv_weight(lds, args.in[I_SWQKV], (bf16_t*)(ws + WS_QKVT), DM, 3072, 3072, 1, 0, 1.f, pr, pn);
        conv_weight(lds, args.in[I_SWWO], (bf16_t*)(ws + WS_SWOT), DM, DM, DM, 0, 0, 1.f, pr, pn);
        conv_weight(lds, args.in[I_W1], W1T, DM, FF, FF, 0, 0, 1.f, pr, pn);
        conv_weight(lds, args.in[I_W2], W2T, FF, DM, DM, 0, 0, 1.f, pr, pn);
        conv_weight(lds, args.in[I_W1] + (size_t)3 * DM * FF, W1T + (size_t)3 * FF * DM, DM, FF, FF, 0, 0, 1.f, pr, pn);
        conv_weight(lds, args.in[I_W2] + (size_t)3 * FF * DM, W2T + (size_t)3 * DM * FF, FF, DM, DM, 0, 0, 1.f, pr, pn);
    }
    PH_END(0)
    SEAM(0);
    int vbid = (int)blockIdx.x;
#if MK_ONE_LAUNCH
    if (IN(0) && IN(1)) {
        if (tid == 0) {
            const unsigned xc = misc[4], rk = misc[5]; unsigned p_ = rk;
            for (unsigned j = 0; j < 16; ++j) { const unsigned cj = xb_ld((unsigned*)(ws + WS_CTL) + 3712 + j); if (j < xc) p_ += cj; }
            const unsigned G_ = gridDim.x, per = G_ >> 3;
            misc[6] = ((G_ & 7u) == 0u && p_ < G_) ? (p_ % per) * 8u + p_ / per : blockIdx.x;
        }
        __syncthreads();
        vbid = (int)misc[6];
    }
#endif
    const int xlid = (gridDim.x == 256) ? (vbid & 7) * 32 + (vbid >> 3) : (int)blockIdx.x;
    PH_BEGIN(1)
        ph_normmod(x, cin, nullptr, true, normg + (0 * 4 + 0) * DM, mods + (size_t)0 * 5 * NMOD, 0, 1, U, RA);
    PH_END(1)
    SEAM(1);
    PH_BEGIN(2)
        {
        EpiG<0> e = mk_epi<0>(ws + WS_QKV, 3072); e.rope = ropeA; e.head_w = 128; e.rope_off = 0; e.rope_cols = 2560; e.tab_stride = 64; e.rope_rows = RL;
        run_gemm<0>(lds, U, (const bf16_t*)(ws + WS_QKVT), RA, 3072, DM, e, vbid);
        int tr_, tn_;
        if (tail_slot((RA / 256) * 12, vbid, tr_, tn_)) {
            __syncthreads();
            conv_weight(lds, args.in[I_MLWIN], (bf16_t*)(ws + WS_MLIN), DM, 6176, 6400, 0, 1024, 0.08838834764831845f, tr_, tn_);
            conv_weight(lds, args.in[I_MLWO], (bf16_t*)(ws + WS_MLO), DM, DM, DM, 0, 0, 1.f, tr_, tn_);
            conv_weight(lds, args.in[I_W1] + (size_t)1 * DM * FF, W1T + (size_t)1 * FF * DM, DM, FF, FF, 0, 0, 1.f, tr_, tn_);
        }
    }
    PH_END(2)
    SEAM(2);
    PH_BEGIN(3)
        {
        const bf16_t* qkv = (const bf16_t*)(ws + WS_QKV);
        const float* sink = args.in[I_SWSINK];
        const float sc = 0.08838834764831845f * LOG2E;
#pragma unroll 1
        for (int ui = blockIdx.x; ui < 1024 + 64; ui += gridDim.x) {
            if (ui < 1024) {
                int u = ui;
                if (gridDim.x == 256) { const int rnd = ui >> 8, xc = vbid & 7, rk = vbid >> 3; u = ((rnd * 8 + xc) << 5) + rk; }
                const int qb = u & 63, kvh = (u >> 6) & 3, b = u >> 8;
                const int t0 = qb * 64, ks = t0 - 128 < 0 ? 0 : t0 - 128, ke = t0 + 192 > SEQ ? SEQ : t0 + 192;
                const int qrow0 = b * SEQ + t0, hq0 = kvh * 4;
                attn_unit<128>(lds, qkv + (size_t)qrow0 * 3072 + hq0 * 128, 3072, qkv + 2048 + kvh * 128, 3072, nullptr, qkv + 2560 + kvh * 128, 3072,
                               b * SEQ + ks, (ke - ks) >> 6, RL + b * CTX, 4, true, ks, t0, sc, true, 0.f, O + (size_t)qrow0 * DM + hq0 * 128, DM, true, sink + hq0);
            } else {
                const int v = ui - 1024, hq = v & 15, b = v >> 4, kvh = hq >> 2, qrow0 = RL + b * CTX;
                attn_unit<128>(lds, qkv + (size_t)qrow0 * 3072 + hq * 128, 3072, qkv + 2048 + kvh * 128, 3072, nullptr, qkv + 2560 + kvh * 128, 3072,
                               0, 0, RL + b * CTX, 4, true, 0, 0, sc, true, sink[hq] * LOG2E, O + (size_t)qrow0 * DM + hq * 128, DM);
            }
        }
    }
    PH_END(3)
    SEAM(3);
    PH_BEGIN(4)
        { EpiG<0> e = mk_epi<0>(Y, DM); run_gemm<0>(lds, O, (const bf16_t*)(ws + WS_SWOT), RL, DM, DM, e, vbid);
          run_gemm_split(lds, O + (size_t)RL * DM, (const bf16_t*)(ws + WS_SWOT), NB * CTX, DM, DM, 8, YP, vbid); }
    PH_END(4)
    SEAM(4);
    PH_BEGIN(5)
        ph_resid<true, false>(lds, Y, YP, normg + (0 * 4 + 1) * DM, mods + (size_t)0 * 5 * NMOD, 2, x, cin, H, H, true, normg + (0 * 4 + 2) * DM, mods + (size_t)0 * 5 * NMOD, 3, 4, U, RA);
    PH_END(5)
    SEAM(5);
    PH_BEGIN(6)
        { EpiG<1> e = mk_epi<1>(T, FF); run_gemm<1, 0, 4>(lds, U, W1T + (size_t)0 * FF * DM, RA, FF, DM, e, vbid);
          int tr_, tn_;
          if (tail_slot((RA / 256) * 32, vbid, tr_, tn_)) {
              __syncthreads();
              conv_weight(lds, args.in[I_W2] + (size_t)1 * FF * DM, W2T + (size_t)1 * DM * FF, FF, DM, DM, 0, 0, 1.f, tr_, tn_);
          } }
    PH_END(6)
    SEAM(6);
    PH_BEGIN(7)
        { EpiG<0> e = mk_epi<0>(Y, DM); run_gemm<0, 0, 4>(lds, T, W2T + (size_t)0 * DM * FF, RL, DM, FF, e, vbid);
          run_gemm_split(lds, T + (size_t)RL * FF, W2T + (size_t)0 * DM * FF, NB * CTX, DM, FF, 8, YP, vbid); }
    PH_END(7)
    SEAM(7);
    PH_BEGIN(8)
        ph_resid<false, false>(lds, Y, YP, normg + (0 * 4 + 3) * DM, mods + (size_t)0 * 5 * NMOD, 5, x, cin, H, H, true, normg + (1 * 4 + 0) * DM, mods + (size_t)1 * 5 * NMOD, 0, 1, U, RA);
    PH_END(8)
    SEAM(8);
    PH_BEGIN(9)
        { EpiG<0> e = mk_epi<0>(ws + WS_Z1, 6400); run_gemm<0>(lds, U, (const bf16_t*)(ws + WS_MLIN), RA, 6400, DM, e, vbid);
          int tr_, tn_;
          if (tail_slot((RA / 256) * 25, vbid, tr_, tn_)) {
              __syncthreads();
              conv_weight(lds, args.in[I_MAWIN], (bf16_t*)(ws + WS_MAIN), DM, 1088, 1280, 2, 0, 1.f, tr_, tn_);
              conv_weight(lds, args.in[I_MAUQ], (bf16_t*)(ws + WS_MUQ), 512, 3072, 3072, 3, 0, 1.f, tr_, tn_);
              conv_weight(lds, args.in[I_MAUKV], (bf16_t*)(ws + WS_MUKV), 512, 4096, 4096, 0, 0, 1.f, tr_, tn_);
              conv_weight(lds, args.in[I_MAWO], (bf16_t*)(ws + WS_MAO), DM, DM, DM, 0, 0, 1.f, tr_, tn_);
          } }
    PH_END(9)
    SEAM(9);
    PH_BEGIN(10)
        ph_ml_p1(lds, (const bf16_t*)(ws + WS_Z1), args.in[I_MLGB], (bf16_t*)(ws + WS_DC), (float*)(ws + WS_DN), (float*)(ws + WS_AC), (float*)(ws + WS_GB), xlid);
    PH_END(10)
    SEAM(10);
    PH_BEGIN(11)
        ph_ml_p2((const bf16_t*)(ws + WS_DC), (const float*)(ws + WS_DN), (const float*)(ws + WS_AC), (bf16_t*)(ws + WS_CS), (float*)(ws + WS_NS));
    PH_END(11)
    SEAM(11);
    PH_BEGIN(12)
        ph_ml_p3(lds, (const bf16_t*)(ws + WS_Z1), (const float*)(ws + WS_GB), (const bf16_t*)(ws + WS_CS), (const float*)(ws + WS_NS), (bf16_t*)(ws + WS_HD), xlid);
    PH_END(12)
    SEAM(12);
    PH_BEGIN(13)
        ph_headnorm((const bf16_t*)(ws + WS_HD), (const bf16_t*)(ws + WS_HD) + (size_t)RA * DM, (const bf16_t*)(ws + WS_Z1), args.in[I_MLHG], O);
    PH_END(13)
    SEAM(13);
    PH_BEGIN(14)
        { EpiG<0> e = mk_epi<0>(Y, DM); run_gemm<0>(lds, O, (const bf16_t*)(ws + WS_MLO), RL, DM, DM, e, vbid);
          run_gemm_split(lds, O + (size_t)RL * DM, (const bf16_t*)(ws + WS_MLO), NB * CTX, DM, DM, 8, YP, vbid); }
    PH_END(14)
    SEAM(14);
    PH_BEGIN(15)
        ph_resid<false, false>(lds, Y, YP, normg + (1 * 4 + 1) * DM, mods + (size_t)1 * 5 * NMOD, 2, x, cin, H, H, true, normg + (1 * 4 + 2) * DM, mods + (size_t)1 * 5 * NMOD, 3, 4, U, RA);
    PH_END(15)
    SEAM(15);
    PH_BEGIN(16)
        { EpiG<1> e = mk_epi<1>(T, FF); run_gemm<1, 0, 4>(lds, U, W1T + (size_t)1 * FF * DM, RA, FF, DM, e, vbid);
          int tr_, tn_;
          if (tail_slot((RA / 256) * 32, vbid, tr_, tn_)) {
              __syncthreads();
              conv_weight(lds, args.in[I_W1] + (size_t)2 * DM * FF, W1T + (size_t)2 * FF * DM, DM, FF, FF, 0, 0, 1.f, tr_, tn_);
          } }
    PH_END(16)
    SEAM(16);
    PH_BEGIN(17)
        { EpiG<0> e = mk_epi<0>(Y, DM); run_gemm<0, 0, 4>(lds, T, W2T + (size_t)1 * DM * FF, RL, DM, FF, e, vbid);
          run_gemm_split(lds, T + (size_t)RL * FF, W2T + (size_t)1 * DM * FF, NB * CTX, DM, FF, 8, YP, vbid); }
    PH_END(17)
    SEAM(17);
    PH_BEGIN(18)
        ph_resid<false, false>(lds, Y, YP, normg + (1 * 4 + 3) * DM, mods + (size_t)1 * 5 * NMOD, 5, x, cin, H, H, true, normg + (2 * 4 + 0) * DM, mods + (size_t)2 * 5 * NMOD, 0, 1, U, RA);
    PH_END(18)
    SEAM(18);
    PH_BEGIN(19)
        { EpiG<0> e = mk_epi<0>(ws + WS_Z2, 1280); run_gemm<0>(lds, U, (const bf16_t*)(ws + WS_MAIN), RA, 1280, DM, e, vbid);
          int tr_, tn_;
          if (tail_slot((RA / 256) * 5, vbid, tr_, tn_)) {
              __syncthreads();
              conv_weight(lds, args.in[I_W2] + (size_t)2 * FF * DM, W2T + (size_t)2 * DM * FF, FF, DM, DM, 0, 0, 1.f, tr_, tn_);
              conv_weight(lds, args.in[I_HYWIN], (bf16_t*)(ws + WS_HYIN), DM, 6144, 6144, 0, 0, 1.f, tr_, tn_);
          } }
    PH_END(19)
    SEAM(19);
    PH_BEGIN(20)
        ph_mla_rows((const bf16_t*)(ws + WS_Z2), args.in[I_MAQG], args.in[I_MAKVG], ropeC, (bf16_t*)(ws + WS_ZQ), (bf16_t*)(ws + WS_ZKV), (bf16_t*)(ws + WS_KR));
    PH_END(20)
    SEAM(20);
    PH_BEGIN(21)
        {
        { EpiG<0> e = mk_epi<0>(ws + WS_Q2, 3072); e.rope = ropeC; e.head_w = 192; e.rope_off = 128; e.rope_cols = 3072; e.tab_stride = 32; e.rope_rows = RL;
          run_gemm<0>(lds, (const bf16_t*)(ws + WS_ZQ), (const bf16_t*)(ws + WS_MUQ), RL, 3072, 512, e, vbid); }
        { EpiG<0> e = mk_epi<0>(ws + WS_KV, 4096); run_gemm<0>(lds, (const bf16_t*)(ws + WS_ZKV), (const bf16_t*)(ws + WS_MUKV), RA, 4096, 512, e, vbid); }
        int tr_, tn_;
        if (tail_slot((RA / 256) * 16, vbid, tr_, tn_)) {
            __syncthreads();
            conv_weight(lds, args.in[I_HYWO], (bf16_t*)(ws + WS_HYO), DM, DM, DM, 0, 0, 1.f, tr_, tn_);
        }
    }
    PH_END(21)
    SEAM(21);
    PH_BEGIN(22)
        {
        const bf16_t* q2 = (const bf16_t*)(ws + WS_Q2); const bf16_t* kv = (const bf16_t*)(ws + WS_KV); const bf16_t* kr = (const bf16_t*)(ws + WS_KR);
        const float sc = 0.07216878364870323f * LOG2E;
#pragma unroll 1
        for (int ui = blockIdx.x; ui < 1024; ui += gridDim.x) {
            int u = ui;
            if (gridDim.x == 256) { const int rnd = ui >> 8, xc = vbid & 7, rk = vbid >> 3; u = (((rnd * 8 + xc) * 2 + (rk >> 4)) << 4) + (rk & 15); }
            const int qb = u & 15, hh = (u >> 4) & 15, b = u >> 8;
            const int qrow0 = b * SEQ + qb * 256;
            attn_unit<192>(lds, q2 + (size_t)qrow0 * 3072 + hh * 192, 3072, kv + hh * 256, 4096, kr, kv + hh * 256 + 128, 4096,
                           b * SEQ, 64, RL + b * CTX, 4, false, 0, 0, sc, false, 0.f, O + (size_t)qrow0 * DM + hh * 128, DM);
        }
    }
    PH_END(22)
    SEAM(22);
    PH_BEGIN(23)
        { EpiG<0> e = mk_epi<0>(Y, DM); run_gemm<0>(lds, O, (const bf16_t*)(ws + WS_MAO), RL, DM, DM, e, vbid); }
    PH_END(23)
    SEAM(23);
    PH_BEGIN(24)
        ph_resid<false, false>(lds, Y, nullptr, normg + (2 * 4 + 1) * DM, mods + (size_t)2 * 5 * NMOD, 2, x, cin, H, H, true, normg + (2 * 4 + 2) * DM, mods + (size_t)2 * 5 * NMOD, 3, 4, U, RL);
    PH_END(24)
    SEAM(24);
    PH_BEGIN(25)
        { EpiG<1> e = mk_epi<1>(T, FF); run_gemm<1, 0, 4>(lds, U, W1T + (size_t)2 * FF * DM, RL, FF, DM, e, vbid); }
    PH_END(25)
    SEAM(25);
    PH_BEGIN(26)
        { EpiG<0> e = mk_epi<0>(Y, DM); run_gemm<0, 0, 4>(lds, T, W2T + (size_t)2 * DM * FF, RL, DM, FF, e, vbid); }
    PH_END(26)
    SEAM(26);
    PH_BEGIN(27)
        {
        ph_resid<false, false>(lds, Y, nullptr, normg + (2 * 4 + 3) * DM, mods + (size_t)2 * 5 * NMOD, 5, x, cin, H, H, true, normg + (3 * 4 + 0) * DM, mods + (size_t)3 * 5 * NMOD, 0, 1, U, RL);
        __syncthreads();
        run_gemm_filt(lds, w4tb, a3b, (bf16_t*)(ws + WS_F), args.in[I_HYB4], args.in[I_HYDECAY], vbid);
        }
    PH_END(27)
    SEAM(27);
    PH_BEGIN(28)
        { EpiG<0> e = mk_epi<0>(ws + WS_ZT, RL); run_gemm<0>(lds, (const bf16_t*)(ws + WS_HYIN), U, 6144, RL, DM, e, vbid); }
    PH_END(28)
    SEAM(28);
    PH_BEGIN(29)
        ph_hyena(lds, (const bf16_t*)(ws + WS_ZT), args.in[I_HYCW], args.in[I_HYCB], (const bf16_t*)(ws + WS_F), args.in[I_HYSKIP], tw, (bf16_t*)(ws + WS_Y2T));
    PH_END(29)
    SEAM(29);
    PH_BEGIN(30)
        ph_transpose(lds, (const bf16_t*)(ws + WS_Y2T), O);
    PH_END(30)
    SEAM(30);
    PH_BEGIN(31)
        { EpiG<0> e = mk_epi<0>(Y, DM); run_gemm<0>(lds, O, (const bf16_t*)(ws + WS_HYO), RL, DM, DM, e, vbid); }
    PH_END(31)
    SEAM(31);
    PH_BEGIN(32)
        ph_resid<false, false>(lds, Y, nullptr, normg + (3 * 4 + 1) * DM, mods + (size_t)3 * 5 * NMOD, 2, x, cin, H, H, true, normg + (3 * 4 + 2) * DM, mods + (size_t)3 * 5 * NMOD, 3, 4, U, RL);
    PH_END(32)
    SEAM(32);
    PH_BEGIN(33)
        { EpiG<1> e = mk_epi<1>(T, FF); run_gemm<1, 0, 4>(lds, U, W1T + (size_t)3 * FF * DM, RL, FF, DM, e, vbid); }
    PH_END(33)
    SEAM(33);
    PH_BEGIN(34)
        {
        EpiG<0> e = mk_epi<0>(Y, DM); run_gemm<0, 0, 4>(lds, T, W2T + (size_t)3 * DM * FF, RL, DM, FF, e, vbid);
        }
    PH_END(34)
    SEAM(34);
    PH_BEGIN(35)
        ph_resid<false, true>(lds, Y, nullptr, normg + (3 * 4 + 3) * DM, mods + (size_t)3 * 5 * NMOD, 5, x, cin, H, args.out, false, nullptr, nullptr, 0, 0, nullptr, RL);
    PH_END(35)
#undef IN
#undef SEAM
}

extern "C" void kernel_launch(void* const* d_in, const int* in_sizes, int n_in, void* d_out, int out_size, void* d_ws, size_t ws_size, hipStream_t stream) {
    static int grid = 0;
    if (grid == 0) {
        if (n_in != N_IN || ws_size < WS_END) { fprintf(stderr, "kernel_launch: expected %d inputs and >= %zu bytes of workspace, got %d / %zu\n", N_IN, (size_t)WS_END, n_in, ws_size); grid = -1; return; }
        int dev = 0, cus = 0, per_cu = 0;
        if (hipGetDevice(&dev) != hipSuccess || hipDeviceGetAttribute(&cus, hipDeviceAttributeMultiprocessorCount, dev) != hipSuccess) { grid = -1; return; }
        if (hipFuncSetAttribute((const void*)mk_fwd, hipFuncAttributeMaxDynamicSharedMemorySize, LDS_BYTES) != hipSuccess) { fprintf(stderr, "kernel_launch: hipFuncSetAttribute failed\n"); grid = -1; return; }
        if (hipOccupancyMaxActiveBlocksPerMultiprocessor(&per_cu, (const void*)mk_fwd, NTHREADS, LDS_BYTES) != hipSuccess || per_cu < 1) { fprintf(stderr, "kernel_launch: occupancy query says %d blocks per CU\n", per_cu); }
        (void)hipGetLastError();
        grid = cus;
    }
    if (grid < 0) return;
    (void)hipMemsetAsync((char*)d_ws + WS_CTL, 0, 16384, stream);
    Args a{};
    for (int i = 0; i < N_IN; ++i) a.in[i] = (const float*)d_in[i];
    a.out = (float*)d_out; a.ws = (unsigned char*)d_ws;
#if MK_ONE_LAUNCH
    a.ph_lo = 0; a.ph_hi = N_PHASES;
    hipLaunchKernelGGL(mk_fwd, dim3(grid), dim3(NTHREADS), LDS_BYTES, stream, a);
#else
    for (int p = 0; p < N_PHASES; ++p) { a.ph_lo = p; a.ph_hi = p + 1; hipLaunchKernelGGL(mk_fwd, dim3(grid), dim3(NTHREADS), LDS_BYTES, stream, a); }
#endif
}
```
